# Optimizing an MI355X kernel written in HIP

```python
import math
import jax, jax.numpy as jnp
from jax import lax
import numpy as np

D_MODEL = 1024
BATCH = 16
SEQ = 4096
DEPTH = 4

CTX_LEN = 256
GRID_W = 64

MLA_HEADS = 8
MLA_Q_RANK = 384
MLA_KV_RANK = 256
MLA_NOPE = 64
MLA_ROPE = 32
MLA_V = 64
MLA_QK = MLA_NOPE + MLA_ROPE
MLA_SCALE = MLA_QK ** -0.5
ATTN_BLOCK = 128
ROPE_BASE = 10000.0

HG_HEADS = 4
HG_DK = 64
HG_DV = 64
HG_CHUNK = 64

SSM_HEADS = 4
SSM_HEADDIM = 64
SSM_GROUPS = 2
SSM_STATE = 64
SSM_CONV = 5
SSM_CHUNK = 128
SSM_INNER = SSM_HEADS * SSM_HEADDIM
SSM_XBC = SSM_INNER + 2 * SSM_GROUPS * SSM_STATE

FFN_HIDDEN = -(-8 * D_MODEL // (3 * 256)) * 256

MLA_COLS = MLA_Q_RANK + MLA_KV_RANK + MLA_ROPE
HG_W = HG_HEADS * HG_DK
HG_COLS = 3 * HG_W + 2 * HG_HEADS * HG_DV
SSM_COLS = SSM_INNER + SSM_XBC + 2 * SSM_HEADS
IN_COLS = MLA_COLS + HG_COLS + SSM_COLS
MIX_WIDTH = MLA_HEADS * MLA_V + HG_HEADS * HG_DV + SSM_INNER

kernel_name = "hybrid_mla_hgrn2_mamba2_diffusion_block"


def rms_norm(x, g, eps=1e-6):
    xf = x.astype(jnp.float32)
    y = xf * lax.rsqrt(jnp.mean(xf * xf, axis=-1, keepdims=True) + eps)
    return (y * g.astype(jnp.float32)).astype(x.dtype)


def modulate(h, shift, scale):
    return h * (1 + scale) + shift


def swiglu(h, w_in, w_out):
    a, b = jnp.split(h @ w_in, 2, axis=-1)
    return (jax.nn.silu(a) * b) @ w_out


def axial_rope_tables(n):
    rows = n // GRID_W
    row = jnp.repeat(jnp.arange(rows, dtype=jnp.float32), GRID_W)
    col = jnp.tile(jnp.arange(GRID_W, dtype=jnp.float32), rows)
    n_freq = MLA_ROPE // 4
    inv = ROPE_BASE ** (-jnp.arange(n_freq, dtype=jnp.float32) / n_freq)
    ang = jnp.stack([row[:, None] * inv, col[:, None] * inv], axis=1)
    return jnp.cos(ang), jnp.sin(ang)


def apply_axial_rope(x, cos, sin):
    xr = x.astype(jnp.float32).reshape(x.shape[:-1] + (2, 2, MLA_ROPE // 4))
    x1, x2 = xr[..., 0, :], xr[..., 1, :]
    out = jnp.stack([x1 * cos - x2 * sin, x2 * cos + x1 * sin], axis=-2)
    return out.reshape(x.shape).astype(x.dtype)


def mla_project(p, qa_g, wqb, kva_g, wkvb):
    bsz, n, _ = p.shape
    q_lat = rms_norm(p[..., :MLA_Q_RANK], qa_g)
    kv_lat = rms_norm(p[..., MLA_Q_RANK:MLA_Q_RANK + MLA_KV_RANK], kva_g)
    k_rope = p[..., MLA_Q_RANK + MLA_KV_RANK:MLA_COLS]
    q = (q_lat @ wqb).reshape(bsz, n, MLA_HEADS, MLA_QK)
    kv = (kv_lat @ wkvb).reshape(bsz, n, MLA_HEADS, MLA_NOPE + MLA_V)
    return q[..., :MLA_NOPE], q[..., MLA_NOPE:], kv[..., :MLA_NOPE], kv[..., MLA_NOPE:], k_rope


def mla_probs(qn, qr, kn, kr):
    s = jnp.einsum('bhqd,bhkd->bhqk', qn, kn) + jnp.einsum('bhqr,bkr->bhqk', qr, kr)
    return jax.nn.softmax(s.astype(jnp.float32) * MLA_SCALE, axis=-1)


def mla_mixer(p_ctx, p_lat, qa_g, wqb, kva_g, wkvb, cos, sin, with_ctx_out):
    bsz, n, _ = p_lat.shape
    n_ctx = p_ctx.shape[1]
    qn_c, qr_c, kn_c, v_c, kr_c = mla_project(p_ctx, qa_g, wqb, kva_g, wkvb)
    qn, qr, kn, v, kr = mla_project(p_lat, qa_g, wqb, kva_g, wkvb)
    qr = apply_axial_rope(qr, cos[:, None], sin[:, None])
    kr = apply_axial_rope(kr, cos, sin)
    heads = lambda a: a.transpose(0, 2, 1, 3)
    kn_all = jnp.concatenate([heads(kn_c), heads(kn)], axis=2)
    v_all = jnp.concatenate([heads(v_c), heads(v)], axis=2)
    kr_all = jnp.concatenate([kr_c, kr], axis=1)
    nb = n // ATTN_BLOCK
    to_blocks = lambda a: a.reshape(bsz, nb, ATTN_BLOCK, MLA_HEADS, a.shape[-1]).transpose(1, 0, 3, 2, 4)

    def block(qs):
        qn_b, qr_b = qs
        pr = mla_probs(qn_b, qr_b, kn_all, kr_all)
        return jnp.einsum('bhqk,bhkd->bhqd', pr.astype(v_all.dtype), v_all)

    o = lax.map(block, (to_blocks(qn), to_blocks(qr)))
    o_lat = o.transpose(1, 0, 3, 2, 4).reshape(bsz, n, MLA_HEADS * MLA_V)
    o_ctx = None
    if with_ctx_out:
        pr = mla_probs(heads(qn_c), heads(qr_c), heads(kn_c), kr_c)
        o_ctx = jnp.einsum('bhqk,bhkd->bqhd', pr.astype(v_c.dtype), heads(v_c)).reshape(bsz, n_ctx, MLA_HEADS * MLA_V)
    return o_lat, o_ctx


def gla_chunk_scan(q, k, logf, v, s0):
    bsz, nh, n, dk = q.shape
    dv = v.shape[-1]
    nc = n // HG_CHUNK
    to_chunks = lambda a: a.reshape(bsz, nh, nc, HG_CHUNK, a.shape[-1]).transpose(2, 0, 1, 3, 4)
    tri = jnp.tril(jnp.ones((HG_CHUNK, HG_CHUNK), bool))[:, :, None]

    def step(S, blk):
        qc, kc, gc, vc = blk
        b = jnp.cumsum(gc, axis=2)
        diff = b[:, :, :, None, :] - b[:, :, None, :, :]
        dec = jnp.where(tri, jnp.exp(jnp.where(tri, diff, 0.0)), 0.0)
        att = jnp.einsum('bhtk,bhsk,bhtsk->bhts', qc, kc, dec)
        o = jnp.einsum('bhts,bhsv->bhtv', att, vc) + jnp.einsum('bhtk,bhkv->bhtv', qc * jnp.exp(b), S)
        b_last = b[:, :, -1:, :]
        S = jnp.exp(b_last[:, :, 0, :, None]) * S + jnp.einsum('bhsk,bhsv->bhkv', kc * jnp.exp(b_last - b), vc)
        return S, o

    S, o = lax.scan(step, s0, (to_chunks(q), to_chunks(k), to_chunks(logf), to_chunks(v)))
    return o.transpose(1, 2, 0, 3, 4).reshape(bsz, nh, n, dv), S


def hgrn_gates(ff, lb):
    lb = lb.astype(jnp.float32).reshape(HG_HEADS, 1, HG_DK)
    f = lb + (1 - lb) * jax.nn.sigmoid(ff)
    k = (1 - lb) * jax.nn.sigmoid(-ff)
    return k, jnp.log(f)


def hgrn_split(p):
    bsz, n, _ = p.shape
    heads = lambda a: a.reshape(bsz, n, HG_HEADS, -1).transpose(0, 2, 1, 3).astype(jnp.float32)
    q = heads(jax.nn.silu(p[..., :HG_W]))
    ff_f = heads(p[..., HG_W:2 * HG_W])
    ff_b = heads(p[..., 2 * HG_W:3 * HG_W])
    iv = heads(p[..., 3 * HG_W:3 * HG_W + HG_HEADS * HG_DV])
    og = p[..., 3 * HG_W + HG_HEADS * HG_DV:]
    return q, ff_f, ff_b, iv, og


def hgrn_bidir(q, ff_f, ff_b, iv, lb_f, lb_b, s0_f, s0_b):
    k_f, g_f = hgrn_gates(ff_f, lb_f)
    o_f, s_f = gla_chunk_scan(q, k_f, g_f, iv, s0_f)
    k_b, g_b = hgrn_gates(ff_b, lb_b)
    flip = lambda a: jnp.flip(a, axis=2)
    o_b, s_b = gla_chunk_scan(flip(q), flip(k_b), flip(g_b), flip(iv), s0_b)
    return o_f + flip(o_b), s_f, s_b


def hgrn_readout(o, og, norm_g):
    bsz, _, n, _ = o.shape
    o = rms_norm(o, norm_g.reshape(HG_HEADS, 1, HG_DV))
    o = o.transpose(0, 2, 1, 3).reshape(bsz, n, HG_HEADS * HG_DV)
    return (o * jax.nn.silu(og.astype(jnp.float32))).astype(og.dtype)


def hgrn_mixer(p_ctx, p_lat, lb_f, lb_b, norm_g, with_ctx_out):
    bsz = p_lat.shape[0]
    zeros = jnp.zeros((bsz, HG_HEADS, HG_DK, HG_DV), jnp.float32)
    qc, ffc_f, ffc_b, ivc, ogc = hgrn_split(p_ctx)
    oc, sc_f, sc_b = hgrn_bidir(qc, ffc_f, ffc_b, ivc, lb_f, lb_b, zeros, zeros)
    q, ff_f, ff_b, iv, og = hgrn_split(p_lat)
    o, _, _ = hgrn_bidir(q, ff_f, ff_b, iv, lb_f, lb_b, sc_f, sc_b)
    o_ctx = hgrn_readout(oc, ogc, norm_g) if with_ctx_out else None
    return hgrn_readout(o, og, norm_g), o_ctx


def seg_decay(a):
    T = a.shape[-1]
    strict = jnp.tril(jnp.ones((T, T), bool), -1)
    lower = jnp.tril(jnp.ones((T, T), bool))
    ae = jnp.where(strict, jnp.broadcast_to(a[..., None], a.shape + (T,)), 0.0)
    cs = jnp.cumsum(ae, axis=-2)
    return jnp.where(lower, jnp.exp(jnp.where(lower, cs, 0.0)), 0.0)


def ssd_chunked(x, a, Bm, Cm, s0):
    bsz, n, nh, hp = x.shape
    nc = n // SSM_CHUNK
    X = x.reshape(bsz, nc, SSM_CHUNK, nh, hp)
    Bc = Bm.reshape(bsz, nc, SSM_CHUNK, nh, -1)
    Cc = Cm.reshape(bsz, nc, SSM_CHUNK, nh, -1)
    A = a.reshape(bsz, nc, SSM_CHUNK, nh).transpose(0, 3, 1, 2)
    A_cs = jnp.cumsum(A, axis=-1)
    L = seg_decay(A)
    scores = jnp.einsum('bclhn,bcshn->bhcls', Cc, Bc) * L
    y_diag = jnp.einsum('bhcls,bcshp->bclhp', scores, X)
    decay_states = jnp.exp(A_cs[..., -1:] - A_cs)
    states = jnp.einsum('bclhn,bhcl,bclhp->bchpn', Bc, decay_states, X)
    states = jnp.concatenate([s0[:, None], states], axis=1)
    decay_chunk = seg_decay(jnp.pad(A_cs[..., -1], ((0, 0), (0, 0), (1, 0))))
    new_states = jnp.einsum('bhzc,bchpn->bzhpn', decay_chunk, states)
    y_off = jnp.einsum('bclhn,bchpn,bhcl->bclhp', Cc, new_states[:, :-1], jnp.exp(A_cs))
    return (y_diag + y_off).reshape(bsz, n, nh, hp), new_states[:, -1]


def depthwise_conv(u, w, b):
    ch = u.shape[-1]
    y = lax.conv_general_dilated(u, w[:, None, :].astype(u.dtype), window_strides=(1,),
                                 padding=[(SSM_CONV // 2, SSM_CONV // 2)],
                                 dimension_numbers=('NWC', 'WIO', 'NWC'), feature_group_count=ch)
    return y + b


def ssm_split(p, conv_w, conv_b):
    bsz, n, _ = p.shape
    z = p[..., :SSM_INNER]
    xbc = jax.nn.silu(depthwise_conv(p[..., SSM_INNER:SSM_INNER + SSM_XBC], conv_w, conv_b)).astype(jnp.float32)
    xs = xbc[..., :SSM_INNER].reshape(bsz, n, SSM_HEADS, SSM_HEADDIM)
    rep = SSM_HEADS // SSM_GROUPS
    grp = lambda a: jnp.repeat(a.reshape(bsz, n, SSM_GROUPS, SSM_STATE), rep, axis=2)
    Bm = grp(xbc[..., SSM_INNER:SSM_INNER + SSM_GROUPS * SSM_STATE])
    Cm = grp(xbc[..., SSM_INNER + SSM_GROUPS * SSM_STATE:])
    dt_raw = p[..., SSM_INNER + SSM_XBC:].astype(jnp.float32).reshape(bsz, n, 2, SSM_HEADS)
    return z, xs, Bm, Cm, dt_raw


def ssm_bidir(xs, Bm, Cm, dt_raw, dt_bias, a_log, s0_f, s0_b):
    dt = jax.nn.softplus(dt_raw + dt_bias.astype(jnp.float32))
    A = -jnp.exp(a_log.astype(jnp.float32))
    y_f, s_f = ssd_chunked(xs * dt[..., 0, :, None], A[0] * dt[..., 0, :], Bm, Cm, s0_f)
    flip = lambda a: jnp.flip(a, axis=1)
    y_b, s_b = ssd_chunked(flip(xs * dt[..., 1, :, None]), flip(A[1] * dt[..., 1, :]), flip(Bm), flip(Cm), s0_b)
    return y_f + flip(y_b), s_f, s_b


def ssm_readout(y, xs, z, d_skip, norm_g):
    bsz, n = z.shape[:2]
    y = (y + d_skip.astype(jnp.float32)[:, None] * xs).reshape(bsz, n, SSM_INNER)
    yz = (y * jax.nn.silu(z.astype(jnp.float32))).reshape(bsz, n, SSM_GROUPS, SSM_INNER // SSM_GROUPS)
    out = rms_norm(yz, norm_g.reshape(SSM_GROUPS, -1))
    return out.reshape(bsz, n, SSM_INNER).astype(z.dtype)


def ssm_mixer(p_ctx, p_lat, conv_w, conv_b, dt_bias, a_log, d_skip, norm_g, with_ctx_out):
    bsz = p_lat.shape[0]
    zeros = jnp.zeros((bsz, SSM_HEADS, SSM_HEADDIM, SSM_STATE), jnp.float32)
    zc, xc, Bc, Cc, dtc = ssm_split(p_ctx, conv_w, conv_b)
    yc, sc_f, sc_b = ssm_bidir(xc, Bc, Cc, dtc, dt_bias, a_log, zeros, zeros)
    z, xs, Bm, Cm, dtr = ssm_split(p_lat, conv_w, conv_b)
    y, _, _ = ssm_bidir(xs, Bm, Cm, dtr, dt_bias, a_log, sc_f, sc_b)
    o_ctx = ssm_readout(yc, xc, zc, d_skip, norm_g) if with_ctx_out else None
    return ssm_readout(y, xs, z, d_skip, norm_g), o_ctx


def setup_inputs(seed: int = 0) -> dict:
    key = jax.random.key(seed)
    ks = jax.random.split(key, 25)
    D = D_MODEL
    nrm = lambda k, shape, scale: jax.random.normal(k, shape, jnp.float32) * scale
    gain = lambda k, shape: 1.0 + 0.02 * jax.random.normal(k, shape, jnp.float32)
    dt0 = jnp.exp(jax.random.uniform(ks[17], (DEPTH, 2, SSM_HEADS), jnp.float32, math.log(1e-3), math.log(1e-1)))
    dt_bias = dt0 + jnp.log(-jnp.expm1(-dt0))
    a_log = jnp.log(jax.random.uniform(ks[18], (DEPTH, 2, SSM_HEADS), jnp.float32, 1.0, 16.0))
    return {
        "x": nrm(ks[0], (BATCH, SEQ, D), 1.0),
        "c": nrm(ks[1], (BATCH, D), 1.0),
        "ctx": nrm(ks[2], (BATCH, CTX_LEN, D), 1.0),
        "c_ctx": nrm(ks[3], (D,), 1.0),
        "w_ada": nrm(ks[4], (DEPTH, D, 6 * D), 0.5 * D ** -0.5),
        "b_ada": nrm(ks[5], (DEPTH, 6 * D), 0.01),
        "norm1_g": gain(ks[6], (DEPTH, D)),
        "norm2_g": gain(ks[7], (DEPTH, D)),
        "w_in": nrm(ks[8], (DEPTH, D, IN_COLS), D ** -0.5),
        "mla_qa_g": gain(ks[9], (DEPTH, MLA_Q_RANK)),
        "mla_wqb": nrm(ks[10], (DEPTH, MLA_Q_RANK, MLA_HEADS * MLA_QK), MLA_Q_RANK ** -0.5),
        "mla_kva_g": gain(ks[11], (DEPTH, MLA_KV_RANK)),
        "mla_wkvb": nrm(ks[12], (DEPTH, MLA_KV_RANK, MLA_HEADS * (MLA_NOPE + MLA_V)), MLA_KV_RANK ** -0.5),
        "hg_lb_logits": nrm(ks[13], (DEPTH, 2, HG_W), 0.1),
        "hg_norm_g": gain(ks[14], (DEPTH, HG_HEADS * HG_DV)),
        "ssm_conv_w": nrm(ks[15], (DEPTH, SSM_CONV, SSM_XBC), SSM_CONV ** -0.5),
        "ssm_conv_b": nrm(ks[16], (DEPTH, SSM_XBC), 0.01),
        "ssm_dt_bias": dt_bias,
        "ssm_a_log": a_log,
        "ssm_d": gain(ks[19], (DEPTH, SSM_HEADS)),
        "ssm_norm_g": gain(ks[20], (DEPTH, SSM_INNER)),
        "w_out": nrm(ks[21], (DEPTH, MIX_WIDTH, D), MIX_WIDTH ** -0.5),
        "w_ffn_in": nrm(ks[22], (DEPTH, D, 2 * FFN_HIDDEN), D ** -0.5),
        "w_ffn_out": nrm(ks[23], (DEPTH, FFN_HIDDEN, D), FFN_HIDDEN ** -0.5),
        "final_g": gain(ks[24], (D,)),
    }


def reference(x, c, ctx, c_ctx, w_ada, b_ada, norm1_g, norm2_g, w_in, mla_qa_g, mla_wqb, mla_kva_g,
              mla_wkvb, hg_lb_logits, hg_norm_g, ssm_conv_w, ssm_conv_b, ssm_dt_bias, ssm_a_log, ssm_d,
              ssm_norm_g, w_out, w_ffn_in, w_ffn_out, final_g):
    n = x.shape[1]
    cos, sin = axial_rope_tables(n)
    lb_soft = jax.nn.softmax(hg_lb_logits.astype(jnp.float32), axis=0)
    lb_all = jnp.cumsum(lb_soft, axis=0) - lb_soft[0]
    silu_c = jax.nn.silu(c)
    silu_cc = jax.nn.silu(c_ctx)
    o1 = MLA_COLS
    o2 = MLA_COLS + HG_COLS
    h_ctx = ctx
    for l in range(DEPTH):
        ctx_out = l < DEPTH - 1
        mod = (silu_c @ w_ada[l] + b_ada[l])[:, None, :]
        modc = silu_cc @ w_ada[l] + b_ada[l]
        sh1, sc1, g1, sh2, sc2, g2 = jnp.split(mod, 6, axis=-1)
        csh1, csc1, cg1, csh2, csc2, cg2 = jnp.split(modc, 6, axis=-1)
        p = modulate(rms_norm(x, norm1_g[l]), sh1, sc1) @ w_in[l]
        pc = modulate(rms_norm(h_ctx, norm1_g[l]), csh1, csc1) @ w_in[l]
        a_lat, a_ctx = mla_mixer(pc[..., :o1], p[..., :o1], mla_qa_g[l], mla_wqb[l], mla_kva_g[l],
                                 mla_wkvb[l], cos, sin, ctx_out)
        r_lat, r_ctx = hgrn_mixer(pc[..., o1:o2], p[..., o1:o2], lb_all[l, 0], lb_all[l, 1], hg_norm_g[l], ctx_out)
        s_lat, s_ctx = ssm_mixer(pc[..., o2:], p[..., o2:], ssm_conv_w[l], ssm_conv_b[l], ssm_dt_bias[l],
                                 ssm_a_log[l], ssm_d[l], ssm_norm_g[l], ctx_out)
        x = x + g1 * (jnp.concatenate([a_lat, r_lat, s_lat], axis=-1) @ w_out[l])
        x = x + g2 * swiglu(modulate(rms_norm(x, norm2_g[l]), sh2, sc2), w_ffn_in[l], w_ffn_out[l])
        if ctx_out:
            h_ctx = h_ctx + cg1 * (jnp.concatenate([a_ctx, r_ctx, s_ctx], axis=-1) @ w_out[l])
            h_ctx = h_ctx + cg2 * swiglu(modulate(rms_norm(h_ctx, norm2_g[l]), csh2, csc2), w_ffn_in[l], w_ffn_out[l])
    return rms_norm(x, final_g)
```

```cpp
#include <hip/hip_runtime.h>
#include <hip/hip_cooperative_groups.h>
#include <cstdio>
namespace cg = cooperative_groups;

typedef unsigned short u16;
using bf16x8 = __attribute__((ext_vector_type(8))) short;
using f32x16 = __attribute__((ext_vector_type(16))) float;
typedef __attribute__((ext_vector_type(2))) float f32x2;
using u32x4 = __attribute__((ext_vector_type(4))) unsigned;
typedef __attribute__((ext_vector_type(2))) __bf16 bf16x2;
#define DI __device__ __forceinline__
#define MFMA32(a, b, c) __builtin_amdgcn_mfma_f32_32x32x16_bf16((a), (b), (c), 0, 0, 0)

constexpr int DM = 1024, NB = 16, SEQ = 4096, CTXL = 256, TPB = 4352, MROWS = NB * TPB, DEPTH = 4;
constexpr int INC = 2728, INP = 2816, FFH = 2816;
constexpr int MT = MROWS / 128;
constexpr int O1 = 672, O2 = 1952;
constexpr float QSCALE = 0.10206207261596577f * 1.4426950408889634f;
constexpr size_t SMEM_BYTES = 76800;

constexpr size_t W_IN = 0;
constexpr size_t W_Q = W_IN + (size_t)INP * 1024;
constexpr size_t W_KV = W_Q + (size_t)768 * 384;
constexpr size_t W_OUT = W_KV + (size_t)1024 * 256;
constexpr size_t W_FI = W_OUT + (size_t)1024 * 1024;
constexpr size_t W_FO = W_FI + (size_t)5632 * 1024;
constexpr size_t W_LAYER = W_FO + (size_t)1024 * FFH;
constexpr int WT_IN = 44 * 16, WT_Q = 12 * 6, WT_KV = 16 * 4, WT_OUT = 16 * 16, WT_FI = 88 * 16, WT_FO = 16 * 44;
constexpr int WT_LAYER = WT_IN + WT_Q + WT_KV + WT_OUT + WT_FI + WT_FO;

struct Params {
  const float *x, *c, *ctx, *c_ctx, *w_ada, *b_ada, *norm1_g, *norm2_g, *w_in, *qa_g, *wqb, *kva_g, *wkvb, *lb_logits,
      *hg_norm_g, *conv_w, *conv_b, *dt_bias, *a_log, *ssm_d, *ssm_norm_g, *w_out, *w_ffn_in, *w_ffn_out, *final_g;
  float* Hl;
  u16* W;
  float* mod;
  float* rope;
  float* lbt;
  float* Hc;
  u16* ACT;
  u16* P;
  u16* Q;
  u16* Kn;
  u16* Vt;
  u16* KR;
  u16* RO;
  u16* RY;
  int* ctr;
  float* DTA;
  unsigned* bar;
};

DI float bf2f(u16 v) { return __uint_as_float((unsigned)v << 16); }
DI unsigned pack2(float a, float b) {
  f32x2 v = {a, b};
  return __builtin_bit_cast(unsigned, __builtin_convertvector(v, bf16x2));
}
DI u16 f2bf(float a) { return (u16)(pack2(a, 0.f) & 0xffffu); }
DI float lo2f(unsigned u) { return __uint_as_float(u << 16); }
DI float hi2f(unsigned u) { return __uint_as_float(u & 0xffff0000u); }
DI float sigmoidf(float x) { return __builtin_amdgcn_rcpf(1.f + __expf(-x)); }
DI float siluf(float x) { return x * __builtin_amdgcn_rcpf(1.f + __expf(-x)); }
DI int opq(int x) { asm volatile("" : "+v"(x)); return x; }
template <int N>
DI float dpp_row_shr(float x) {
  return __builtin_bit_cast(float, __builtin_amdgcn_update_dpp(0, __builtin_bit_cast(int, x), 0x110 + N, 0xf, 0xf, true));
}
template <int CTRL>
DI float dpp_f(float x) {
  return __builtin_bit_cast(float, __builtin_amdgcn_update_dpp(0, __builtin_bit_cast(int, x), CTRL, 0xf, 0xf, true));
}
DI float row_sum16(float x) {
  x += dpp_f<0xB1>(x); x += dpp_f<0x4E>(x); x += dpp_f<0x141>(x); x += dpp_f<0x140>(x);
  return x;
}
DI float rdlane(float x, int l) { return __builtin_bit_cast(float, __builtin_amdgcn_readlane(__builtin_bit_cast(int, x), l)); }
DI float wave_sum(float x) {
  x = row_sum16(x);
  return (rdlane(x, 0) + rdlane(x, 16)) + (rdlane(x, 32) + rdlane(x, 48));
}
DI int crow(int i, int h) { return (i & 3) + 8 * (i >> 2) + 4 * h; }
DI void unpack8(const u32x4 r, float* f) {
  f[0] = lo2f(r.x); f[1] = hi2f(r.x); f[2] = lo2f(r.y); f[3] = hi2f(r.y);
  f[4] = lo2f(r.z); f[5] = hi2f(r.z); f[6] = lo2f(r.w); f[7] = hi2f(r.w);
}

DI void wconv_tile(const Params& p, int t, char* smem) {
  const int l = t / WT_LAYER;
  int r = t % WT_LAYER;
  const float* src; const float* gk = nullptr; u16* dst; int K, Nsrc, ntn, kind;
  u16* Wl = p.W + (size_t)l * W_LAYER;
  if (r < WT_IN) { src = p.w_in + (size_t)l * 1024 * INC; dst = Wl + W_IN; K = 1024; Nsrc = INC; ntn = 44; kind = 0; }
  else if ((r -= WT_IN) < WT_Q) { src = p.wqb + (size_t)l * 384 * 768; dst = Wl + W_Q; K = 384; Nsrc = 768; ntn = 12; kind = 1; gk = p.qa_g + l * 384; }
  else if ((r -= WT_Q) < WT_KV) { src = p.wkvb + (size_t)l * 256 * 1024; dst = Wl + W_KV; K = 256; Nsrc = 1024; ntn = 16; kind = 1; gk = p.kva_g + l * 256; }
  else if ((r -= WT_KV) < WT_OUT) { src = p.w_out + (size_t)l * 1024 * 1024; dst = Wl + W_OUT; K = 1024; Nsrc = 1024; ntn = 16; kind = 1; }
  else if ((r -= WT_OUT) < WT_FI) { src = p.w_ffn_in + (size_t)l * 1024 * 5632; dst = Wl + W_FI; K = 1024; Nsrc = 5632; ntn = 88; kind = 2; }
  else { r -= WT_FI; src = p.w_ffn_out + (size_t)l * FFH * 1024; dst = Wl + W_FO; K = FFH; Nsrc = 1024; ntn = 16; kind = 1; }
  const int n0 = (r % ntn) * 64, k0 = (r / ntn) * 64;
  float* tile = (float*)smem;
  const int tid = opq(threadIdx.x & 255);
  {
    const int nn4 = (tid & 15) * 4, kk = tid >> 4;
    const int n = n0 + nn4;
    int sn; bool valid = true;
    if (kind == 2) { const int j = n >> 6, w = n & 63; sn = (w < 32) ? (32 * j + w) : (FFH + 32 * j + (w - 32)); }
    else { sn = n; if (kind == 0) valid = n < INC; }
#pragma unroll
    for (int i = 0; i < 4; ++i) {
      const int k = k0 + kk + 16 * i;
      float4 v = make_float4(0.f, 0.f, 0.f, 0.f);
      if (valid) v = *(const float4*)(src + (size_t)k * Nsrc + sn);
      if (gk) { const float g = gk[k]; v.x *= g; v.y *= g; v.z *= g; v.w *= g; }
      float* tp = tile + (kk + 16 * i) * 65 + nn4;
      tp[0] = v.x; tp[1] = v.y; tp[2] = v.z; tp[3] = v.w;
    }
  }
  __syncthreads();
  {
    const int nn = tid >> 2, kq = (tid & 3) * 16;
    unsigned o[8];
#pragma unroll
    for (int i = 0; i < 8; ++i) o[i] = pack2(tile[(kq + 2 * i) * 65 + nn], tile[(kq + 2 * i + 1) * 65 + nn]);
    uint4* d = (uint4*)(dst + (size_t)(n0 + nn) * K + k0 + kq);
    d[0] = make_uint4(o[0], o[1], o[2], o[3]);
    d[1] = make_uint4(o[4], o[5], o[6], o[7]);
  }
  __syncthreads();
}

DI void ada_tile(const Params& p, int t, char* smem) {
  const int l = t / 96, cb = (t % 96) * 64;
  float* sc = (float*)smem;
  const int tid = opq(threadIdx.x & 255);
  for (int i = tid; i < 17 * 1024; i += 256) {
    const int r = i >> 10, k = i & 1023;
    const float v = (r < 16) ? p.c[r * 1024 + k] : p.c_ctx[k];
    sc[i] = siluf(v);
  }
  __syncthreads();
  const int col = tid & 63, kq = tid >> 6;
  float acc[17];
#pragma unroll
  for (int r = 0; r < 17; ++r) acc[r] = 0.f;
  const float* wp = p.w_ada + ((size_t)l * 1024 + kq * 256) * 6144 + cb + col;
  for (int k = 0; k < 256; k += 4) {
    const float w0 = wp[(size_t)(k + 0) * 6144], w1 = wp[(size_t)(k + 1) * 6144], w2 = wp[(size_t)(k + 2) * 6144], w3 = wp[(size_t)(k + 3) * 6144];
#pragma unroll
    for (int r = 0; r < 17; ++r) {
      const float4 s = *(const float4*)(sc + r * 1024 + kq * 256 + k);
      acc[r] = fmaf(s.x, w0, fmaf(s.y, w1, fmaf(s.z, w2, fmaf(s.w, w3, acc[r]))));
    }
  }
  __syncthreads();
  float* red = (float*)smem;
#pragma unroll
  for (int r = 0; r < 17; ++r) red[(kq * 17 + r) * 64 + col] = acc[r];
  __syncthreads();
  for (int i = tid; i < 17 * 64; i += 256) {
    const int r = i >> 6, cc = i & 63;
    const float v = red[(0 * 17 + r) * 64 + cc] + red[(1 * 17 + r) * 64 + cc] + red[(2 * 17 + r) * 64 + cc] + red[(3 * 17 + r) * 64 + cc];
    p.mod[((size_t)l * 17 + r) * 6144 + cb + cc] = v + p.b_ada[l * 6144 + cb + cc];
  }
  __syncthreads();
}

DI void tables(const Params& p) {
  const int tid = opq(threadIdx.x);
  for (int i = tid; i < 512; i += 256) {
    const int pos = i >> 3, f = i & 7;
    const float inv = powf(10000.f, -(float)f / 8.f);
    const float ang = (float)pos * inv;
    p.rope[i * 2] = cosf(ang);
    p.rope[i * 2 + 1] = sinf(ang);
  }
  for (int i = tid; i < 512; i += 256) {
    float lg[4], mx = -1e30f;
#pragma unroll
    for (int l = 0; l < 4; ++l) { lg[l] = p.lb_logits[l * 512 + i]; mx = fmaxf(mx, lg[l]); }
    float s = 0.f;
#pragma unroll
    for (int l = 0; l < 4; ++l) { lg[l] = expf(lg[l] - mx); s += lg[l]; }
    float cum = 0.f;
#pragma unroll
    for (int l = 0; l < 4; ++l) { if (l > 0) cum += lg[l] / s; p.lbt[l * 512 + i] = cum; }
  }
}

DI const float* hrow_in(const Params& p, int row) {
  const int b = row / TPB, tt = row % TPB;
  if (tt < CTXL) return p.Hc + ((size_t)b * CTXL + tt) * DM;
  return p.Hl + ((size_t)b * SEQ + (tt - CTXL)) * DM;
}
DI void norm_tile(const Params& p, int l, int which, int t, bool first = false) {
  const int tid_ = opq(threadIdx.x & 255); const int lane = tid_ & 63, wid = tid_ >> 6;
  const float* ng = (which ? p.norm2_g : p.norm1_g) + l * DM;
  const int row0 = t * 32 + wid * 8;
  const int b = row0 / TPB, tt0 = row0 % TPB;
  const float* md = p.mod + ((size_t)l * 17 + (tt0 < CTXL ? 16 : b)) * 6144 + which * 3072;
  float4 G[4], SH[4];
#pragma unroll
  for (int j = 0; j < 4; ++j) {
    const int col = lane * 4 + 256 * j;
    const float4 g = *(const float4*)(ng + col);
    const float4 sc = *(const float4*)(md + 1024 + col);
    SH[j] = *(const float4*)(md + col);
    G[j] = make_float4(g.x * (1.f + sc.x), g.y * (1.f + sc.y), g.z * (1.f + sc.z), g.w * (1.f + sc.w));
  }
  float* hres = (float*)hrow_in(p, row0);
  const float* h0 = hres;
  if (first) h0 = (tt0 < CTXL) ? p.ctx + ((size_t)b * CTXL + tt0) * DM : p.x + ((size_t)b * SEQ + (tt0 - CTXL)) * DM;
#pragma unroll 1
  for (int rr = 0; rr < 8; rr += 2) {
    float4 v[2][4];
    float ss[2] = {0.f, 0.f};
#pragma unroll
    for (int u = 0; u < 2; ++u)
#pragma unroll
      for (int j = 0; j < 4; ++j) {
        v[u][j] = *(const float4*)(h0 + (size_t)(rr + u) * DM + lane * 4 + 256 * j);
        if (first) *(float4*)(hres + (size_t)(rr + u) * DM + lane * 4 + 256 * j) = v[u][j];
      }
#pragma unroll
    for (int u = 0; u < 2; ++u)
#pragma unroll
      for (int j = 0; j < 4; ++j)
        ss[u] += v[u][j].x * v[u][j].x + v[u][j].y * v[u][j].y + v[u][j].z * v[u][j].z + v[u][j].w * v[u][j].w;
    ss[0] = wave_sum(ss[0]); ss[1] = wave_sum(ss[1]);
#pragma unroll
    for (int u = 0; u < 2; ++u) {
      const float r = rsqrtf(ss[u] * (1.f / DM) + 1e-6f);
#pragma unroll
      for (int j = 0; j < 4; ++j) {
        uint2 o;
        o.x = pack2(v[u][j].x * r * G[j].x + SH[j].x, v[u][j].y * r * G[j].y + SH[j].y);
        o.y = pack2(v[u][j].z * r * G[j].z + SH[j].z, v[u][j].w * r * G[j].w + SH[j].w);
        *(uint2*)(p.ACT + (size_t)(row0 + rr + u) * DM + lane * 4 + 256 * j) = o;
      }
    }
  }
}

enum { EPI_P = 0, EPI_Q = 1, EPI_KV = 2, EPI_RES = 3, EPI_SWIGLU = 4 };

template <int EPI, int MB, int NWC>
DI void gemm_epi(const Params& p, int l, f32x16 (&acc)[MB][2], const float* rs, int mt, int nt, int gofs,
                 int wr, int wc, int lr, int lh) {
  lr = opq(lr); lh = opq(lh); wr = opq(wr);
  constexpr int TM = MB * 64, TN = NWC * 64, TPBT = TPB / TM, WRS = MB * 32;
  const int bidx = mt / TPBT, tt0 = (mt % TPBT) * TM;
  const bool isctx = tt0 < CTXL;
  if (EPI == EPI_P) {
#pragma unroll
    for (int nb = 0; nb < 2; ++nb) {
      const int cblk = nt * (NWC * 2) + wc * 2 + nb;
      const int col = cblk * 32 + lr;
      const int kind = (cblk >= 21 && cblk < 29) ? 1 : ((cblk >= 29 && cblk < 45) ? 2 : 0);
      float oml = 0.f;
      if (kind == 2) oml = 1.f - p.lbt[l * 512 + (col - 928)];
#pragma unroll
      for (int mb = 0; mb < MB; ++mb)
#pragma unroll
        for (int i = 0; i < 16; ++i) {
          const int row = mt * TM + wr * WRS + mb * 32 + crow(i, lh);
          float v = acc[mb][nb][i];
          if (kind == 1) v = siluf(v);
          else if (kind == 2) v = -oml * __builtin_amdgcn_rcpf(1.f + __expf(v));
          *(u16*)((char*)p.P + (unsigned)((row * INP + col) * 2)) = f2bf(v);
        }
    }
  } else if (EPI == EPI_Q) {
#pragma unroll
    for (int nb = 0; nb < 2; ++nb) {
      const int cblk = nt * (NWC * 2) + wc * 2 + nb;
      const bool ropeblk = (cblk % 3) == 2;
#pragma unroll
      for (int mb = 0; mb < MB; ++mb)
#pragma unroll
        for (int i = 0; i < 16; ++i) {
          const int rl = wr * WRS + mb * 32 + crow(i, lh);
          float v = acc[mb][nb][i] * rs[rl] * QSCALE;
          if (ropeblk && !isctx) {
            const float pv = dpp_f<0x128>(v);
            const int t = tt0 - CTXL + rl;
            const int pos = (lr & 16) ? (t & 63) : (t >> 6);
            const float2 cs = *(const float2*)(p.rope + (pos * 8 + (lr & 7)) * 2);
            v = (lr & 8) ? (v * cs.x + pv * cs.y) : (v * cs.x - pv * cs.y);
          }
          *(u16*)((char*)p.Q + (unsigned)(((mt * TM + rl) * 768 + cblk * 32 + lr) * 2)) = f2bf(v);
          if ((i & 7) == 7) __builtin_amdgcn_sched_barrier(0);
        }
    }
  } else if (EPI == EPI_KV) {
    const int head = (nt * NWC + wc) >> 1;
    if ((wc & 1) == 0) {
#pragma unroll
      for (int mb = 0; mb < MB; ++mb)
#pragma unroll
        for (int nb = 0; nb < 2; ++nb)
#pragma unroll
          for (int i = 0; i < 16; ++i) {
            const int rl = wr * WRS + mb * 32 + crow(i, lh);
            *(u16*)((char*)p.Kn + (unsigned)(((mt * TM + rl) * 512 + head * 64 + nb * 32 + lr) * 2)) = f2bf(acc[mb][nb][i] * rs[rl]);
          }
    } else {
#pragma unroll
      for (int mb = 0; mb < MB; ++mb)
#pragma unroll
        for (int nb = 0; nb < 2; ++nb)
#pragma unroll
          for (int g = 0; g < 4; ++g) {
            const int rl = wr * WRS + mb * 32 + 8 * g + 4 * lh;
            uint2 o;
            o.x = pack2(acc[mb][nb][4 * g] * rs[rl], acc[mb][nb][4 * g + 1] * rs[rl + 1]);
            o.y = pack2(acc[mb][nb][4 * g + 2] * rs[rl + 2], acc[mb][nb][4 * g + 3] * rs[rl + 3]);
            const int vd = nb * 32 + lr;
            *(uint2*)(p.Vt + ((size_t)(bidx * 8 + head) * 64 + vd) * TPB + tt0 + rl) = o;
          }
    }
  } else if (EPI == EPI_RES) {
    float* Hout = isctx ? p.Hc + ((size_t)bidx * CTXL + tt0) * DM : p.Hl + ((size_t)bidx * SEQ + tt0 - CTXL) * DM;
    const float* gate = p.mod + ((size_t)l * 17 + (isctx ? 16 : bidx)) * 6144 + gofs;
#pragma unroll
    for (int nb = 0; nb < 2; ++nb) {
      const int col = nt * TN + wc * 64 + nb * 32 + lr;
      const float gv = gate[col];
#pragma unroll
      for (int mb = 0; mb < MB; ++mb)
#pragma unroll
        for (int i = 0; i < 16; ++i) {
          const int rl = wr * WRS + mb * 32 + crow(i, lh);
          unsafeAtomicAdd((float*)((char*)Hout + (unsigned)((rl * DM + col) * 4)), gv * acc[mb][nb][i]);
          if ((i & 3) == 3) __builtin_amdgcn_sched_barrier(0);
        }
    }
  } else if (EPI == EPI_SWIGLU) {
#pragma unroll
    for (int mb = 0; mb < MB; ++mb)
#pragma unroll
      for (int i = 0; i < 16; ++i) {
        const int row = mt * TM + wr * WRS + mb * 32 + crow(i, lh);
        const float a = acc[mb][0][i], b = acc[mb][1][i];
        *(u16*)((char*)p.P + (unsigned)((row * FFH + (nt * NWC + wc) * 32 + lr) * 2)) = f2bf(siluf(a) * b);
      }
  }
}

template <int EPI, bool RSQ, bool DEEP>
DI void gemm_phase(const Params& p, int l, const u16* __restrict__ A, int lda, const u16* __restrict__ Bt, int K,
                   int ntiles_n, int gofs, char* smem, int vbid, int nvblk) {
  const int xcd = vbid & 7, lb = vbid >> 3, nlb = nvblk >> 3;
  constexpr int per = MT / 8;
  const int total = per * ntiles_n;
  auto decode = [&](int t, int& mt, int& nt) {
    const int grp = t / (8 * ntiles_n);
    const int rem = t - grp * 8 * ntiles_n;
    const int gsz = min(8, per - grp * 8);
    nt = rem / gsz;
    mt = per * xcd + grp * 8 + (rem - nt * gsz);
  };
  if (lb >= total) return;
  const int tid = opq(threadIdx.x & 255), lane = tid & 63, wid = tid >> 6, wr = wid >> 1, wc = wid & 1;
  const int lr = lane & 31, lh = lane >> 5;
  const int srow = tid >> 3, sch = tid & 7;
  const int nk = K >> 6;
  float* rs = (float*)(smem + 73728);
  int t = lb, mt, nt, kt = 0, cur = 0;
  decode(t, mt, nt);
  int Lt = lb, Lkt = 0;
  bool Lvalid = true;
  const u16* LA = A + (size_t)(mt * 128 + srow) * lda + sch * 8;
  const u16* LB = Bt + (size_t)(nt * 128 + srow) * K + sch * 8;
  auto issue = [&](u32x4 (&qa)[4], u32x4 (&qb)[4]) {
#pragma unroll
    for (int i = 0; i < 4; ++i) {
      qa[i] = *(const u32x4*)(LA + (size_t)(32 * i) * lda + Lkt * 64);
      qb[i] = *(const u32x4*)(LB + (size_t)(32 * i) * K + Lkt * 64);
    }
    if (++Lkt == nk) {
      Lkt = 0; Lt += nlb;
      if (Lt < total) {
        int a, b; decode(Lt, a, b);
        LA = A + (size_t)(a * 128 + srow) * lda + sch * 8;
        LB = Bt + (size_t)(b * 128 + srow) * K + sch * 8;
      } else Lvalid = false;
    }
  };
  float ssq[4] = {0.f, 0.f, 0.f, 0.f};
  auto stash = [&](u32x4 (&qa)[4], u32x4 (&qb)[4], int stage) {
    char* As = smem + stage * 36864;
    char* Bs = As + 18432;
#pragma unroll
    for (int i = 0; i < 4; ++i) {
      if (RSQ) { float f[8]; unpack8(qa[i], f);
#pragma unroll
        for (int e = 0; e < 8; ++e) ssq[i] = fmaf(f[e], f[e], ssq[i]); }
      *(u32x4*)(As + (srow + 32 * i) * 144 + sch * 16) = qa[i];
      *(u32x4*)(Bs + (srow + 32 * i) * 144 + sch * 16) = qb[i];
    }
  };
  auto stash_part = [&](u32x4 (&qa)[4], u32x4 (&qb)[4], int stage, int i) {
    char* As = smem + stage * 36864;
    char* Bs = As + 18432;
    if (RSQ) { float f[8]; unpack8(qa[i], f);
#pragma unroll
      for (int e = 0; e < 8; ++e) ssq[i] = fmaf(f[e], f[e], ssq[i]); }
    *(u32x4*)(As + (srow + 32 * i) * 144 + sch * 16) = qa[i];
    *(u32x4*)(Bs + (srow + 32 * i) * 144 + sch * 16) = qb[i];
  };
  u32x4 ra0[4], rb0[4], ra1[4], rb1[4];
  f32x16 acc[2][2];
#pragma unroll
  for (int a = 0; a < 2; ++a)
#pragma unroll
    for (int b = 0; b < 2; ++b)
#pragma unroll
      for (int i = 0; i < 16; ++i) acc[a][b][i] = 0.f;
  issue(ra0, rb0);
  bool v1 = DEEP && Lvalid;
  if (v1) issue(ra1, rb1);
  stash(ra0, rb0, 0);
  __syncthreads();
  auto body = [&](u32x4 (&La)[4], u32x4 (&Lb)[4], bool& Lset_valid, u32x4 (&Sa)[4], u32x4 (&Sb)[4], const bool& Sset_valid) -> bool {
    const bool last = (kt == nk - 1);
    Lset_valid = Lvalid;
    if (Lset_valid) issue(La, Lb);
    {
      const char* As = smem + cur * 36864;
      const char* Bs = As + 18432;
      const char* ap = As + (wr * 64 + lr) * 144 + lh * 16;
      const char* bp = Bs + (wc * 64 + lr) * 144 + lh * 16;
      bf16x8 fa[2][2], fb[2][2];
      fa[0][0] = *(const bf16x8*)(ap);
      fb[0][0] = *(const bf16x8*)(bp);
      fb[0][1] = *(const bf16x8*)(bp + 32 * 144);
      fa[0][1] = *(const bf16x8*)(ap + 32 * 144);
#pragma unroll
      for (int ks = 0; ks < 4; ++ks) {
        const int cu = ks & 1, nx = cu ^ 1;
        if (ks < 3) {
          fa[nx][0] = *(const bf16x8*)(ap + (ks + 1) * 32);
          fb[nx][0] = *(const bf16x8*)(bp + (ks + 1) * 32);
          fb[nx][1] = *(const bf16x8*)(bp + 32 * 144 + (ks + 1) * 32);
          fa[nx][1] = *(const bf16x8*)(ap + 32 * 144 + (ks + 1) * 32);
        }
        __builtin_amdgcn_sched_barrier(0);
        __builtin_amdgcn_s_setprio(1);
        acc[0][0] = MFMA32(fa[cu][0], fb[cu][0], acc[0][0]);
        acc[0][1] = MFMA32(fa[cu][0], fb[cu][1], acc[0][1]);
        acc[1][0] = MFMA32(fa[cu][1], fb[cu][0], acc[1][0]);
        acc[1][1] = MFMA32(fa[cu][1], fb[cu][1], acc[1][1]);
        __builtin_amdgcn_s_setprio(0);
        __builtin_amdgcn_sched_barrier(0);
      }
    }
    if (last) {
      if (RSQ) {
#pragma unroll
        for (int i = 0; i < 4; ++i) {
          float v = ssq[i];
          v += dpp_f<0xB1>(v); v += dpp_f<0x4E>(v); v += dpp_f<0x141>(v);
          if (sch == 0) rs[srow + 32 * i] = rsqrtf(v / (float)K + 1e-6f);
          ssq[i] = 0.f;
        }
        __syncthreads();
      }
      gemm_epi<EPI, 2, 2>(p, l, acc, rs, mt, nt, gofs, wr, wc, lr, lh);
#pragma unroll
      for (int a = 0; a < 2; ++a)
#pragma unroll
        for (int b = 0; b < 2; ++b)
#pragma unroll
          for (int i = 0; i < 16; ++i) acc[a][b][i] = 0.f;
    }
    if (Sset_valid) stash(Sa, Sb, cur ^ 1);
    __syncthreads();
    cur ^= 1;
    if (last) {
      t += nlb;
      if (t >= total) return false;
      decode(t, mt, nt);
      kt = 0;
    } else {
      ++kt;
    }
    return true;
  };
  bool v0 = false;
#pragma unroll 1
  for (;;) {
    if (DEEP) {
      if (!body(ra0, rb0, v0, ra1, rb1, v1)) break;
      if (!body(ra1, rb1, v1, ra0, rb0, v0)) break;
    } else {
      if (!body(ra0, rb0, v0, ra0, rb0, v0)) break;
    }
  }
}

template <int EPI, bool RSQ>
DI void gemm_phase8(const Params& p, int l, const u16* __restrict__ A, int lda, const u16* __restrict__ Bt, int K,
                   int ntiles_n, int gofs, char* smem, bool latonly = false) {
  const int xcd = blockIdx.x & 7, lb = blockIdx.x >> 3, nlb = gridDim.x >> 3;
  constexpr bool DEEP = false;
  constexpr int perfull = (MROWS / 256) / 8;
  const int per = latonly ? 32 : perfull;
  const int total = per * ntiles_n;
  auto decode = [&](int t, int& mt, int& nt) {
    const int grp = t / (8 * ntiles_n);
    const int rem = t - grp * 8 * ntiles_n;
    const int gsz = min(8, per - grp * 8);
    nt = rem / gsz;
    const int m = grp * 8 + (rem - nt * gsz);
    mt = perfull * xcd + (latonly ? (m >> 4) * 17 + 1 + (m & 15) : m);
  };
  if (lb >= total) return;
  const int tid = opq(threadIdx.x), lane = tid & 63, wid = tid >> 6, wr = wid >> 2, wc = wid & 3;
  const int lr = lane & 31, lh = lane >> 5;
  const int srow = tid >> 3, sch = tid & 7;
  const int nk = K >> 6;
  float* rs = (float*)(smem + 147456);
  int t = lb, mt, nt, kt = 0, cur = 0;
  decode(t, mt, nt);
  int Lt = lb, Lkt = 0;
  bool Lvalid = true;
  unsigned LAo = (unsigned)((mt * 256 + srow) * lda + sch * 8) * 2u;
  unsigned LBo = (unsigned)((nt * 256 + srow) * K + sch * 8) * 2u;
  const unsigned strideA = (unsigned)(64 * lda) * 2u, strideB = (unsigned)(64 * K) * 2u;
  auto issue = [&](u32x4 (&qa)[4], u32x4 (&qb)[4]) {
#pragma unroll
    for (int i = 0; i < 4; ++i) {
      qa[i] = *(const u32x4*)((const char*)A + (LAo + i * strideA + (unsigned)Lkt * 128u));
      qb[i] = *(const u32x4*)((const char*)Bt + (LBo + i * strideB + (unsigned)Lkt * 128u));
    }
    if (++Lkt == nk) {
      Lkt = 0; Lt += nlb;
      if (Lt < total) {
        int a, b; decode(Lt, a, b);
        LAo = (unsigned)((a * 256 + srow) * lda + sch * 8) * 2u;
        LBo = (unsigned)((b * 256 + srow) * K + sch * 8) * 2u;
      } else Lvalid = false;
    }
  };
  float ssq[4] = {0.f, 0.f, 0.f, 0.f};
  auto stash = [&](u32x4 (&qa)[4], u32x4 (&qb)[4], int stage) {
    char* As = smem + stage * 73728;
    char* Bs = As + 36864;
#pragma unroll
    for (int i = 0; i < 4; ++i) {
      if (RSQ) { float f[8]; unpack8(qa[i], f);
#pragma unroll
        for (int e = 0; e < 8; ++e) ssq[i] = fmaf(f[e], f[e], ssq[i]); }
      *(u32x4*)(As + (srow + 64 * i) * 144 + sch * 16) = qa[i];
      *(u32x4*)(Bs + (srow + 64 * i) * 144 + sch * 16) = qb[i];
    }
  };
  auto stash_part = [&](u32x4 (&qa)[4], u32x4 (&qb)[4], int stage, int i) {
    char* As = smem + stage * 73728;
    char* Bs = As + 36864;
    if (RSQ) { float f[8]; unpack8(qa[i], f);
#pragma unroll
      for (int e = 0; e < 8; ++e) ssq[i] = fmaf(f[e], f[e], ssq[i]); }
    *(u32x4*)(As + (srow + 64 * i) * 144 + sch * 16) = qa[i];
    *(u32x4*)(Bs + (srow + 64 * i) * 144 + sch * 16) = qb[i];
  };
  u32x4 ra0[4], rb0[4], ra1[4], rb1[4];
  f32x16 acc[4][2];
#pragma unroll
  for (int a = 0; a < 4; ++a)
#pragma unroll
    for (int b = 0; b < 2; ++b)
#pragma unroll
      for (int i = 0; i < 16; ++i) acc[a][b][i] = 0.f;
  issue(ra0, rb0);
  bool v1 = DEEP && Lvalid;
  if (v1) issue(ra1, rb1);
  stash(ra0, rb0, 0);
  __syncthreads();
  auto body = [&](u32x4 (&La)[4], u32x4 (&Lb)[4], bool& Lset_valid, u32x4 (&Sa)[4], u32x4 (&Sb)[4], const bool& Sset_valid) -> bool {
    const bool last = (kt == nk - 1);
    Lset_valid = Lvalid;
    if (Lset_valid) issue(La, Lb);
    {
      const char* As = smem + cur * 73728;
      const char* Bs = As + 36864;
      const char* ap = As + (wr * 128 + lr) * 144 + lh * 16;
      const char* bp = Bs + (wc * 64 + lr) * 144 + lh * 16;
      bf16x8 fa[4][2], fb[2][2];
      fa[0][0] = *(const bf16x8*)(ap);
      fa[0][1] = *(const bf16x8*)(ap + 32 * 144);
      fb[0][0] = *(const bf16x8*)(bp);
      fb[0][1] = *(const bf16x8*)(bp + 32 * 144);
      fa[1][0] = *(const bf16x8*)(ap + 2 * 32 * 144);
      fa[1][1] = *(const bf16x8*)(ap + 3 * 32 * 144);
      fb[1][0] = *(const bf16x8*)(bp + 32);
      fb[1][1] = *(const bf16x8*)(bp + 32 * 144 + 32);
      fa[2][0] = *(const bf16x8*)(ap + 32);
      fa[2][1] = *(const bf16x8*)(ap + 32 * 144 + 32);
#pragma unroll
      for (int u = 0; u < 8; ++u) {
        const int ks = u >> 1, hf = u & 1, ca = u & 3, cb = ks & 1;
        if (u + 3 < 8) {
          const int ks2 = (u + 3) >> 1, hf2 = (u + 3) & 1, cn = (u + 3) & 3;
          fa[cn][0] = *(const bf16x8*)(ap + (2 * hf2) * 32 * 144 + ks2 * 32);
          fa[cn][1] = *(const bf16x8*)(ap + (2 * hf2 + 1) * 32 * 144 + ks2 * 32);
        }
        __builtin_amdgcn_sched_barrier(0);
        __builtin_amdgcn_s_setprio(1);
        acc[2 * hf][0] = MFMA32(fa[ca][0], fb[cb][0], acc[2 * hf][0]);
        acc[2 * hf][1] = MFMA32(fa[ca][0], fb[cb][1], acc[2 * hf][1]);
        acc[2 * hf + 1][0] = MFMA32(fa[ca][1], fb[cb][0], acc[2 * hf + 1][0]);
        acc[2 * hf + 1][1] = MFMA32(fa[ca][1], fb[cb][1], acc[2 * hf + 1][1]);
        __builtin_amdgcn_s_setprio(0);
        __builtin_amdgcn_sched_barrier(0);
        if (hf == 1 && ks + 2 < 4) {
          fb[cb][0] = *(const bf16x8*)(bp + (ks + 2) * 32);
          fb[cb][1] = *(const bf16x8*)(bp + 32 * 144 + (ks + 2) * 32);
          __builtin_amdgcn_sched_barrier(0);
        }
      }
    }
    if (last) {
      if (RSQ) {
#pragma unroll
        for (int i = 0; i < 4; ++i) {
          float v = ssq[i];
          v += dpp_f<0xB1>(v); v += dpp_f<0x4E>(v); v += dpp_f<0x141>(v);
          if (sch == 0) rs[srow + 64 * i] = rsqrtf(v / (float)K + 1e-6f);
          ssq[i] = 0.f;
        }
        __syncthreads();
      }
      gemm_epi<EPI, 4, 4>(p, l, acc, rs, mt, nt, gofs, wr, wc, lr, lh);
#pragma unroll
      for (int a = 0; a < 4; ++a)
#pragma unroll
        for (int b = 0; b < 2; ++b)
#pragma unroll
          for (int i = 0; i < 16; ++i) acc[a][b][i] = 0.f;
    }
    if (Sset_valid) stash(Sa, Sb, cur ^ 1);
    __syncthreads();
    cur ^= 1;
    if (last) {
      t += nlb;
      if (t >= total) return false;
      decode(t, mt, nt);
      kt = 0;
    } else {
      ++kt;
    }
    return true;
  };
  bool v0 = false;
#pragma unroll 1
  for (;;) {
    if (DEEP) {
      if (!body(ra0, rb0, v0, ra1, rb1, v1)) break;
      if (!body(ra1, rb1, v1, ra0, rb0, v0)) break;
    } else {
      if (!body(ra0, rb0, v0, ra0, rb0, v0)) break;
    }
  }
}

DI void krope_tile(const Params& p, int t) {
  const int tid = opq(threadIdx.x & 255);
  const int sub = tid & 15, axis = sub >> 3, f = sub & 7;
#pragma unroll 1
  for (int it = 0; it < 8; ++it) {
    const int row = t * 128 + it * 16 + (tid >> 4);
    const int tt = row % TPB;
    const u16* src = p.P + (size_t)row * INP + 640 + axis * 16 + f;
    float x1 = bf2f(src[0]), x2 = bf2f(src[8]);
    if (tt >= CTXL) {
      const int tl = tt - CTXL;
      const int pos = axis ? (tl & 63) : (tl >> 6);
      const float2 cs = *(const float2*)(p.rope + (pos * 8 + f) * 2);
      const float y1 = x1 * cs.x - x2 * cs.y, y2 = x2 * cs.x + x1 * cs.y;
      x1 = y1; x2 = y2;
    }
    u16* dst = p.KR + (size_t)row * 32 + axis * 16 + f;
    dst[0] = f2bf(x1); dst[8] = f2bf(x2);
  }
}

DI void hgrn_chain(const Params& p, int l, int cid, char* smem) {
  const int b = cid >> 3, hh = (cid >> 1) & 3, dir = cid & 1;
  const int tid = opq(threadIdx.x & 255), lane = tid & 63, w = tid >> 6, lr = lane & 31, lh = lane >> 5;
  const int pb = w >> 1, jb = w & 1;
  float* bm = (float*)smem;
  float* tot = bm + 4096;
  float* er = tot + 256;
  float* ed = er + 64;
  char* Qd = (char*)(ed + 64);
  char* Kd = Qd + 9216;
  char* Kt = Kd + 9216;
  char* Vt = Kt + 9216;
  const size_t rowbase = (size_t)b * TPB;
  auto ttlo_of = [&](int c) { return dir ? (c < 4 ? 192 - 64 * c : 4544 - 64 * c) : 64 * c; };
  const int r = tid >> 2, q4 = tid & 3;
  const int jst = dir ? 63 - r : r;
  u32x4 rq[2], rn[2], rv[2];
  auto load_regs = [&](int c) {
    const u16* src = p.P + (rowbase + ttlo_of(c) + r) * INP + O1 + hh * 64 + q4 * 16;
    rq[0] = *(const u32x4*)(src); rq[1] = *(const u32x4*)(src + 8);
    rn[0] = *(const u32x4*)(src + 256 + dir * 256); rn[1] = *(const u32x4*)(src + 256 + dir * 256 + 8);
    rv[0] = *(const u32x4*)(src + 768); rv[1] = *(const u32x4*)(src + 768 + 8);
  };
  f32x16 Sacc[2];
#pragma unroll
  for (int i = 0; i < 16; ++i) { Sacc[0][i] = 0.f; Sacc[1][i] = 0.f; }
  load_regs(0);
  constexpr int NCH = TPB / 64;
#pragma unroll 1
  for (int c = 0; c < NCH; ++c) {
    const int tl = ttlo_of(c);
    float qv[16], kv[16];
    {
      float nk[16], vv[16];
      unpack8(rq[0], qv); unpack8(rq[1], qv + 8);
      unpack8(rn[0], nk); unpack8(rn[1], nk + 8);
      unpack8(rv[0], vv); unpack8(rv[1], vv + 8);
      float g[16];
#pragma unroll
      for (int e = 0; e < 16; ++e) { kv[e] = -nk[e]; g[e] = __logf(fmaxf(1.f + nk[e], 2e-9f)); }
      float* gd = bm + jst * 64 + q4 * 16;
#pragma unroll
      for (int e4 = 0; e4 < 4; ++e4) *(float4*)(gd + 4 * e4) = make_float4(g[4 * e4], g[4 * e4 + 1], g[4 * e4 + 2], g[4 * e4 + 3]);
#pragma unroll
      for (int e = 0; e < 16; ++e) *(u16*)(Vt + (q4 * 16 + e) * 144 + jst * 2) = f2bf(vv[e]);
    }
    if (c + 1 < NCH) load_regs(c + 1);
    __syncthreads();
    {
      const int kc = tid & 63, qt = tid >> 6;
      float loc[16];
#pragma unroll
      for (int i = 0; i < 16; ++i) loc[i] = bm[(16 * qt + i) * 64 + kc];
#pragma unroll
      for (int i = 1; i < 16; ++i) loc[i] += loc[i - 1];
      tot[qt * 64 + kc] = loc[15];
      __syncthreads();
      float off = 0.f;
#pragma unroll
      for (int q = 0; q < 3; ++q) if (q < qt) off += tot[q * 64 + kc];
#pragma unroll
      for (int i = 0; i < 16; ++i) bm[(16 * qt + i) * 64 + kc] = loc[i] + off;
    }
    __syncthreads();
    {
      const float* bj = bm + jst * 64 + q4 * 16;
      const float* br = bm + 31 * 64 + q4 * 16;
      unsigned qo[8], ko[8];
      float qdv[16], kd[16];
#pragma unroll
      for (int e = 0; e < 16; ++e) {
        const float d = bj[e] - br[e];
        qdv[e] = qv[e] * __expf(d);
        kd[e] = kv[e] * __expf(-d);
      }
#pragma unroll
      for (int e = 0; e < 8; ++e) { qo[e] = pack2(qdv[2 * e], qdv[2 * e + 1]); ko[e] = pack2(kd[2 * e], kd[2 * e + 1]); }
      *(u32x4*)(Qd + jst * 144 + q4 * 32) = (u32x4){qo[0], qo[1], qo[2], qo[3]};
      *(u32x4*)(Qd + jst * 144 + q4 * 32 + 16) = (u32x4){qo[4], qo[5], qo[6], qo[7]};
      *(u32x4*)(Kd + jst * 144 + q4 * 32) = (u32x4){ko[0], ko[1], ko[2], ko[3]};
      *(u32x4*)(Kd + jst * 144 + q4 * 32 + 16) = (u32x4){ko[4], ko[5], ko[6], ko[7]};
#pragma unroll
      for (int e = 0; e < 16; ++e) *(u16*)(Kt + (q4 * 16 + e) * 144 + jst * 2) = f2bf(kd[e]);
      if (tid < 64) {
        const float r31 = bm[31 * 64 + tid];
        er[tid] = __expf(r31);
        ed[tid] = __expf(bm[63 * 64 + tid] - r31);
      }
    }
    __syncthreads();
    {
      const int jg = 32 * jb + lr;
      bf16x8 qfr[4];
#pragma unroll
      for (int ks = 0; ks < 4; ++ks) qfr[ks] = *(const bf16x8*)(Qd + jg * 144 + ks * 32 + lh * 16);
      f32x16 st[2];
#pragma unroll
      for (int i = 0; i < 16; ++i) { st[0][i] = 0.f; st[1][i] = 0.f; }
#pragma unroll
      for (int sb = 0; sb < 2; ++sb)
#pragma unroll
        for (int ks = 0; ks < 4; ++ks) {
          const bf16x8 kfr = *(const bf16x8*)(Kd + (32 * sb + lr) * 144 + ks * 32 + lh * 16);
          st[sb] = MFMA32(kfr, qfr[ks], st[sb]);
        }
      f32x16 acc;
#pragma unroll
      for (int i = 0; i < 16; ++i) acc[i] = 0.f;
#pragma unroll
      for (int nb = 0; nb < 2; ++nb) {
#pragma unroll
        for (int g = 0; g < 4; ++g) {
          const float4 e4 = *(const float4*)(er + 32 * nb + 8 * g + 4 * lh);
          Sacc[nb][4 * g] *= e4.x; Sacc[nb][4 * g + 1] *= e4.y; Sacc[nb][4 * g + 2] *= e4.z; Sacc[nb][4 * g + 3] *= e4.w;
        }
#pragma unroll
        for (int s2 = 0; s2 < 2; ++s2) {
          u32x4 pk;
          pk.x = pack2(Sacc[nb][8 * s2 + 0], Sacc[nb][8 * s2 + 1]);
          pk.y = pack2(Sacc[nb][8 * s2 + 2], Sacc[nb][8 * s2 + 3]);
          pk.z = pack2(Sacc[nb][8 * s2 + 4], Sacc[nb][8 * s2 + 5]);
          pk.w = pack2(Sacc[nb][8 * s2 + 6], Sacc[nb][8 * s2 + 7]);
          const char* cp = Qd + jg * 144 + (32 * nb + 16 * s2 + 4 * lh) * 2;
          const uint2 c0 = *(const uint2*)(cp);
          const uint2 c1 = *(const uint2*)(cp + 16);
          const bf16x8 qperm = __builtin_bit_cast(bf16x8, ((u32x4){c0.x, c0.y, c1.x, c1.y}));
          acc = MFMA32(__builtin_bit_cast(bf16x8, pk), qperm, acc);
        }
      }
#pragma unroll
      for (int sb = 0; sb < 2; ++sb) {
#pragma unroll
        for (int i = 0; i < 16; ++i) {
          const int sg = 32 * sb + crow(i, lh);
          st[sb][i] = (sg <= jg) ? st[sb][i] : 0.f;
        }
#pragma unroll
        for (int s2 = 0; s2 < 2; ++s2) {
          u32x4 pk;
          pk.x = pack2(st[sb][8 * s2 + 0], st[sb][8 * s2 + 1]);
          pk.y = pack2(st[sb][8 * s2 + 2], st[sb][8 * s2 + 3]);
          pk.z = pack2(st[sb][8 * s2 + 4], st[sb][8 * s2 + 5]);
          pk.w = pack2(st[sb][8 * s2 + 6], st[sb][8 * s2 + 7]);
          const char* xp = Vt + (32 * pb + lr) * 144 + (32 * sb + 16 * s2 + 4 * lh) * 2;
          const uint2 x0 = *(const uint2*)(xp);
          const uint2 x1 = *(const uint2*)(xp + 16);
          const bf16x8 vfr = __builtin_bit_cast(bf16x8, ((u32x4){x0.x, x0.y, x1.x, x1.y}));
          acc = MFMA32(vfr, __builtin_bit_cast(bf16x8, pk), acc);
        }
      }
      {
        const int tt = dir ? tl + 63 - jg : tl + jg;
        u16* op = p.RO + (rowbase + tt) * 512 + dir * 256 + hh * 64 + 32 * pb + 4 * lh;
#pragma unroll
        for (int g = 0; g < 4; ++g) {
          uint2 o;
          o.x = pack2(acc[4 * g], acc[4 * g + 1]);
          o.y = pack2(acc[4 * g + 2], acc[4 * g + 3]);
          *(uint2*)(op + 8 * g) = o;
        }
      }
#pragma unroll
      for (int nb = 0; nb < 2; ++nb) {
#pragma unroll
        for (int ks = 0; ks < 4; ++ks) {
          const bf16x8 afr = *(const bf16x8*)(Kt + (32 * nb + lr) * 144 + ks * 32 + lh * 16);
          const bf16x8 bfr = *(const bf16x8*)(Vt + (32 * pb + lr) * 144 + ks * 32 + lh * 16);
          Sacc[nb] = MFMA32(afr, bfr, Sacc[nb]);
        }
#pragma unroll
        for (int g = 0; g < 4; ++g) {
          const float4 e4 = *(const float4*)(ed + 32 * nb + 8 * g + 4 * lh);
          Sacc[nb][4 * g] *= e4.x; Sacc[nb][4 * g + 1] *= e4.y; Sacc[nb][4 * g + 2] *= e4.z; Sacc[nb][4 * g + 3] *= e4.w;
        }
      }
    }
    __syncthreads();
  }
}

DI void ssmprep_tile(const Params& p, int l, int t) {
  const int tid_ = opq(threadIdx.x & 255); const int lane = tid_ & 63, wid = tid_ >> 6;
  const int c8 = lane * 8;
  float cw[5][8], cb[8];
#pragma unroll
  for (int e = 0; e < 8; ++e) {
    cb[e] = p.conv_b[l * 512 + c8 + e];
#pragma unroll
    for (int j = 0; j < 5; ++j) cw[j][e] = p.conv_w[((size_t)l * 5 + j) * 512 + c8 + e];
  }
  const int dcol = (c8 < 256) ? 768 + c8 : ((c8 < 384) ? 512 + (c8 - 256) : 640 + (c8 - 384));
  float dtb = 0.f, An = 0.f;
  if (lane < 8) { dtb = p.dt_bias[l * 8 + lane]; An = -expf(p.a_log[l * 8 + lane]); }
#pragma unroll 2
  for (int rr = 0; rr < 8; ++rr) {
    const int row = t * 32 + wid * 8 + rr;
    const int tt = row % TPB;
    const int seglo = (tt < CTXL) ? 0 : CTXL, seghi = (tt < CTXL) ? CTXL : TPB;
    const u16* Pr = p.P + (size_t)row * INP + O2 + 256 + c8;
    float a[8];
#pragma unroll
    for (int e = 0; e < 8; ++e) a[e] = cb[e];
#pragma unroll
    for (int j = 0; j < 5; ++j) {
      const int t2 = tt + j - 2;
      if (t2 >= seglo && t2 < seghi) {
        const u32x4 u = *(const u32x4*)(Pr + (ptrdiff_t)(j - 2) * INP);
        float f[8]; unpack8(u, f);
#pragma unroll
        for (int e = 0; e < 8; ++e) a[e] = fmaf(cw[j][e], f[e], a[e]);
      }
    }
    uint4 ov;
    ov.x = pack2(siluf(a[0]), siluf(a[1])); ov.y = pack2(siluf(a[2]), siluf(a[3]));
    ov.z = pack2(siluf(a[4]), siluf(a[5])); ov.w = pack2(siluf(a[6]), siluf(a[7]));
    *(uint4*)(p.ACT + (size_t)row * DM + dcol) = ov;
    if (lane < 8) {
      const float dr = bf2f(p.P[(size_t)row * INP + O2 + 768 + lane]) + dtb;
      const float dt = (dr > 20.f) ? dr : log1pf(expf(dr));
      p.DTA[(size_t)row * 16 + lane] = dt;
      p.DTA[(size_t)row * 16 + 8 + lane] = An * dt;
    }
  }
}

DI void ssm_chain(const Params& p, int l, int cid, char* smem) {
  const int b = cid >> 3, hh = (cid >> 1) & 3, dir = cid & 1, grp = hh >> 1;
  const int tid = opq(threadIdx.x & 255), lane = tid & 63, w = tid >> 6, lr = lane & 31, lh = lane >> 5;
  const int pb = w >> 1, jb = w & 1;
  char* Cq = smem;
  char* Bk = Cq + 9216;
  char* Btr = Bk + 9216;
  char* XT = Btr + 9216;
  char* XTs = XT + 8704;
  float* csm = (float*)(XTs + 9216);
  const size_t rowbase = (size_t)b * TPB;
  auto ttlo_of = [&](int c) { return dir ? (c < 4 ? 192 - 64 * c : 4544 - 64 * c) : 64 * c; };
  const int r = tid >> 2, q4 = tid & 3;
  const int jst = dir ? 63 - r : r;
  u32x4 rx[2], rB[2], rC[2];
  float rdt;
  auto load_regs = [&](int c) {
    const size_t row = rowbase + ttlo_of(c) + r;
    const u16* src = p.ACT + row * DM;
    rx[0] = *(const u32x4*)(src + 768 + hh * 64 + q4 * 16); rx[1] = *(const u32x4*)(src + 768 + hh * 64 + q4 * 16 + 8);
    rB[0] = *(const u32x4*)(src + 512 + grp * 64 + q4 * 16); rB[1] = *(const u32x4*)(src + 512 + grp * 64 + q4 * 16 + 8);
    rC[0] = *(const u32x4*)(src + 640 + grp * 64 + q4 * 16); rC[1] = *(const u32x4*)(src + 640 + grp * 64 + q4 * 16 + 8);
    rdt = p.DTA[row * 16 + dir * 4 + hh];
  };
  f32x16 Sacc[2];
#pragma unroll
  for (int i = 0; i < 16; ++i) { Sacc[0][i] = 0.f; Sacc[1][i] = 0.f; }
  load_regs(0);
  constexpr int NCH = TPB / 64;
#pragma unroll 1
  for (int c = 0; c < NCH; ++c) {
    const int tl = ttlo_of(c);
    if (w == 0) {
      const int tt = dir ? tl + 63 - lane : tl + lane;
      float a = p.DTA[(rowbase + tt) * 16 + 8 + dir * 4 + hh];
#pragma unroll
      for (int o = 1; o < 64; o <<= 1) { const float t = __shfl_up(a, o); if (lane >= o) a += t; }
      csm[lane] = a;
    }
    __syncthreads();
    {
      const float wj = __expf(csm[63] - csm[jst]);
      *(u32x4*)(Cq + jst * 144 + q4 * 32) = rC[0]; *(u32x4*)(Cq + jst * 144 + q4 * 32 + 16) = rC[1];
      *(u32x4*)(Bk + jst * 144 + q4 * 32) = rB[0]; *(u32x4*)(Bk + jst * 144 + q4 * 32 + 16) = rB[1];
      float xb[16], bb[16];
      unpack8(rx[0], xb); unpack8(rx[1], xb + 8);
      unpack8(rB[0], bb); unpack8(rB[1], bb + 8);
#pragma unroll
      for (int e = 0; e < 16; ++e) {
        const int ch = q4 * 16 + e;
        const float xd = xb[e] * rdt;
        *(u16*)(Btr + ch * 144 + jst * 2) = f2bf(bb[e]);
        *(u16*)(XT + ch * 136 + jst * 2) = f2bf(xd);
        *(u16*)(XTs + ch * 144 + jst * 2) = f2bf(xd * wj);
      }
    }
    if (c + 1 < NCH) load_regs(c + 1);
    __syncthreads();
    {
      const int jg = 32 * jb + lr;
      const float csj = csm[jg];
      const float decay_all = __expf(csm[63]);
      bf16x8 cfr[4];
#pragma unroll
      for (int ks = 0; ks < 4; ++ks) cfr[ks] = *(const bf16x8*)(Cq + jg * 144 + ks * 32 + lh * 16);
      f32x16 st[2];
#pragma unroll
      for (int i = 0; i < 16; ++i) { st[0][i] = 0.f; st[1][i] = 0.f; }
#pragma unroll
      for (int sb = 0; sb < 2; ++sb)
#pragma unroll
        for (int ks = 0; ks < 4; ++ks) {
          const bf16x8 bfr = *(const bf16x8*)(Bk + (32 * sb + lr) * 144 + ks * 32 + lh * 16);
          st[sb] = MFMA32(bfr, cfr[ks], st[sb]);
        }
      f32x16 acc2;
#pragma unroll
      for (int i = 0; i < 16; ++i) acc2[i] = 0.f;
#pragma unroll
      for (int nb = 0; nb < 2; ++nb)
#pragma unroll
        for (int s2 = 0; s2 < 2; ++s2) {
          u32x4 pk;
          pk.x = pack2(Sacc[nb][8 * s2 + 0], Sacc[nb][8 * s2 + 1]);
          pk.y = pack2(Sacc[nb][8 * s2 + 2], Sacc[nb][8 * s2 + 3]);
          pk.z = pack2(Sacc[nb][8 * s2 + 4], Sacc[nb][8 * s2 + 5]);
          pk.w = pack2(Sacc[nb][8 * s2 + 6], Sacc[nb][8 * s2 + 7]);
          const char* cp = Cq + jg * 144 + (32 * nb + 16 * s2 + 4 * lh) * 2;
          const uint2 c0 = *(const uint2*)(cp);
          const uint2 c1 = *(const uint2*)(cp + 16);
          const bf16x8 cperm = __builtin_bit_cast(bf16x8, ((u32x4){c0.x, c0.y, c1.x, c1.y}));
          acc2 = MFMA32(__builtin_bit_cast(bf16x8, pk), cperm, acc2);
        }
      f32x16 acc;
#pragma unroll
      for (int i = 0; i < 16; ++i) acc[i] = 0.f;
#pragma unroll
      for (int sb = 0; sb < 2; ++sb) {
#pragma unroll
        for (int g = 0; g < 4; ++g) {
          const float4 c4 = *(const float4*)(csm + 32 * sb + 8 * g + 4 * lh);
          const float cv[4] = {c4.x, c4.y, c4.z, c4.w};
#pragma unroll
          for (int e = 0; e < 4; ++e) {
            const int sg = 32 * sb + 8 * g + 4 * lh + e;
            const float f = __expf(csj - cv[e]);
            st[sb][4 * g + e] = (sg <= jg) ? st[sb][4 * g + e] * f : 0.f;
          }
        }
#pragma unroll
        for (int s2 = 0; s2 < 2; ++s2) {
          u32x4 pk;
          pk.x = pack2(st[sb][8 * s2 + 0], st[sb][8 * s2 + 1]);
          pk.y = pack2(st[sb][8 * s2 + 2], st[sb][8 * s2 + 3]);
          pk.z = pack2(st[sb][8 * s2 + 4], st[sb][8 * s2 + 5]);
          pk.w = pack2(st[sb][8 * s2 + 6], st[sb][8 * s2 + 7]);
          const char* xp = XT + (32 * pb + lr) * 136 + (32 * sb + 16 * s2 + 4 * lh) * 2;
          const uint2 x0 = *(const uint2*)(xp);
          const uint2 x1 = *(const uint2*)(xp + 16);
          const bf16x8 xfr = __builtin_bit_cast(bf16x8, ((u32x4){x0.x, x0.y, x1.x, x1.y}));
          acc = MFMA32(xfr, __builtin_bit_cast(bf16x8, pk), acc);
        }
      }
      {
        const float ej = __expf(csj);
        const int tt = dir ? tl + 63 - jg : tl + jg;
        u16* op = p.RY + (rowbase + tt) * 512 + dir * 256 + hh * 64 + 32 * pb + 4 * lh;
#pragma unroll
        for (int g = 0; g < 4; ++g) {
          uint2 o;
          o.x = pack2(acc[4 * g] + ej * acc2[4 * g], acc[4 * g + 1] + ej * acc2[4 * g + 1]);
          o.y = pack2(acc[4 * g + 2] + ej * acc2[4 * g + 2], acc[4 * g + 3] + ej * acc2[4 * g + 3]);
          *(uint2*)(op + 8 * g) = o;
        }
      }
#pragma unroll
      for (int nb = 0; nb < 2; ++nb) {
#pragma unroll
        for (int i = 0; i < 16; ++i) Sacc[nb][i] *= decay_all;
#pragma unroll
        for (int ks = 0; ks < 4; ++ks) {
          const bf16x8 afr = *(const bf16x8*)(Btr + (32 * nb + lr) * 144 + ks * 32 + lh * 16);
          const bf16x8 bfr = *(const bf16x8*)(XTs + (32 * pb + lr) * 144 + ks * 32 + lh * 16);
          Sacc[nb] = MFMA32(afr, bfr, Sacc[nb]);
        }
      }
    }
    __syncthreads();
  }
}

DI void readout_tile(const Params& p, int l, int t) {
  const int tid_ = opq(threadIdx.x & 255); const int lane = tid_ & 63, wid = tid_ >> 6;
  const int c4 = lane * 4;
  float hg[4], sg[4], dsk;
#pragma unroll
  for (int e = 0; e < 4; ++e) {
    hg[e] = p.hg_norm_g[l * 256 + c4 + e];
    sg[e] = p.ssm_norm_g[l * 256 + c4 + e];
  }
  dsk = p.ssm_d[l * 4 + (lane >> 4)];
#pragma unroll 2
  for (int rr = 0; rr < 8; ++rr) {
    const int row = t * 32 + wid * 8 + rr;
    const int tt = row % TPB;
    const u16* Pr = p.P + (size_t)row * INP;
    {
      const uint2 of = *(const uint2*)(p.RO + (size_t)row * 512 + c4);
      const uint2 obk = *(const uint2*)(p.RO + (size_t)row * 512 + 256 + c4);
      const uint2 og = *(const uint2*)(Pr + O1 + 1024 + c4);
      float o[4] = {lo2f(of.x) + lo2f(obk.x), hi2f(of.x) + hi2f(obk.x), lo2f(of.y) + lo2f(obk.y), hi2f(of.y) + hi2f(obk.y)};
      float ss = o[0] * o[0] + o[1] * o[1] + o[2] * o[2] + o[3] * o[3];
      ss = row_sum16(ss);
      const float r = rsqrtf(ss * (1.f / 64.f) + 1e-6f);
      const float g[4] = {lo2f(og.x), hi2f(og.x), lo2f(og.y), hi2f(og.y)};
      uint2 ov;
      ov.x = pack2(o[0] * r * hg[0] * siluf(g[0]), o[1] * r * hg[1] * siluf(g[1]));
      ov.y = pack2(o[2] * r * hg[2] * siluf(g[2]), o[3] * r * hg[3] * siluf(g[3]));
      *(uint2*)(p.ACT + (size_t)row * DM + 512 + c4) = ov;
    }
    {
      const uint2 yf = *(const uint2*)(p.RY + (size_t)row * 512 + c4);
      const uint2 yb = *(const uint2*)(p.RY + (size_t)row * 512 + 256 + c4);
      const uint2 zz = *(const uint2*)(Pr + O2 + c4);
      const uint2 xc = *(const uint2*)(p.ACT + (size_t)row * DM + 768 + c4);
      const float a[4] = {lo2f(xc.x), hi2f(xc.x), lo2f(xc.y), hi2f(xc.y)};
      const float z[4] = {lo2f(zz.x), hi2f(zz.x), lo2f(zz.y), hi2f(zz.y)};
      const float yy[4] = {lo2f(yf.x) + lo2f(yb.x), hi2f(yf.x) + hi2f(yb.x), lo2f(yf.y) + lo2f(yb.y), hi2f(yf.y) + hi2f(yb.y)};
      float v[4], ss = 0.f;
#pragma unroll
      for (int e = 0; e < 4; ++e) { v[e] = (yy[e] + dsk * a[e]) * siluf(z[e]); ss = fmaf(v[e], v[e], ss); }
      ss = row_sum16(ss);
      {
        const float lo = rdlane(ss, 0) + rdlane(ss, 16), hi = rdlane(ss, 32) + rdlane(ss, 48);
        ss = (lane < 32) ? lo : hi;
      }
      const float r = rsqrtf(ss * (1.f / 128.f) + 1e-6f);
      uint2 ov;
      ov.x = pack2(v[0] * r * sg[0], v[1] * r * sg[1]);
      ov.y = pack2(v[2] * r * sg[2], v[3] * r * sg[3]);
      *(uint2*)(p.ACT + (size_t)row * DM + 768 + c4) = ov;
    }
  }
}

DI void attn_tile(const Params& p, int bh, int qt, char* smem) {
  const int b = bh >> 3, hh = bh & 7;
  const int nkt = (qt < 2) ? 4 : 68;
  const int tid = opq(threadIdx.x), lane = tid & 63, w = tid >> 6, lr = lane & 31, lh = lane >> 5;
  const size_t rowbase = (size_t)b * TPB;
  const size_t qrow = rowbase + qt * 128 + w * 32 + lr;
  bf16x8 qf[6];
  {
    const u16* qp = p.Q + qrow * 768 + hh * 96 + lh * 8;
#pragma unroll
    for (int s = 0; s < 6; ++s) qf[s] = *(const bf16x8*)(qp + 16 * s);
  }
  u32x4 rk[3], rv[2];
  auto load_tiles = [&](int kt) {
#pragma unroll
    for (int i = 0; i < 3; ++i) {
      const int idx = tid + 256 * i, key = idx / 12, ch = idx % 12;
      const size_t kr = rowbase + kt * 64 + key;
      rk[i] = (ch < 8) ? *(const u32x4*)(p.Kn + kr * 512 + hh * 64 + ch * 8) : *(const u32x4*)(p.KR + kr * 32 + (ch - 8) * 8);
    }
#pragma unroll
    for (int i = 0; i < 2; ++i) {
      const int idx = tid + 256 * i, vd = idx >> 3, ch = idx & 7;
      rv[i] = *(const u32x4*)(p.Vt + ((size_t)bh * 64 + vd) * TPB + kt * 64 + ch * 8);
    }
  };
  auto store_tiles = [&](int st) {
    char* Ks = smem + st * 22016;
    char* Vs = Ks + 13312;
#pragma unroll
    for (int i = 0; i < 3; ++i) {
      const int idx = tid + 256 * i, key = idx / 12, ch = idx % 12;
      *(u32x4*)(Ks + key * 208 + ch * 16) = rk[i];
    }
#pragma unroll
    for (int i = 0; i < 2; ++i) {
      const int idx = tid + 256 * i, vd = idx >> 3, ch = idx & 7;
      uint2* d = (uint2*)(Vs + vd * 136 + ch * 16);
      d[0] = make_uint2(rv[i].x, rv[i].y);
      d[1] = make_uint2(rv[i].z, rv[i].w);
    }
  };
  f32x16 O[2];
#pragma unroll
  for (int i = 0; i < 16; ++i) { O[0][i] = 0.f; O[1][i] = 0.f; }
  float m = -1e30f, lsum = 0.f;
  load_tiles(0);
  store_tiles(0);
  __syncthreads();
#pragma unroll 1
  for (int kt = 0; kt < nkt; ++kt) {
    const bool more = kt + 1 < nkt;
    if (more) load_tiles(kt + 1);
    const char* Ks = smem + (kt & 1) * 22016;
    const char* Vs = Ks + 13312;
    f32x16 st[2];
#pragma unroll
    for (int i = 0; i < 16; ++i) { st[0][i] = 0.f; st[1][i] = 0.f; }
    {
      bf16x8 kf[2][6];
#pragma unroll
      for (int kb = 0; kb < 2; ++kb)
#pragma unroll
        for (int s = 0; s < 6; ++s) kf[kb][s] = *(const bf16x8*)(Ks + (kb * 32 + lr) * 208 + s * 32 + lh * 16);
      __builtin_amdgcn_s_setprio(1);
#pragma unroll
      for (int s = 0; s < 6; ++s) {
        st[0] = MFMA32(kf[0][s], qf[s], st[0]);
        st[1] = MFMA32(kf[1][s], qf[s], st[1]);
      }
      __builtin_amdgcn_s_setprio(0);
    }
    u32x4 vf[2][2][2];
#pragma unroll
    for (int kb = 0; kb < 2; ++kb)
#pragma unroll
      for (int s2 = 0; s2 < 2; ++s2)
#pragma unroll
        for (int vb = 0; vb < 2; ++vb) {
          const char* vp = Vs + (vb * 32 + lr) * 136 + (kb * 32 + 16 * s2 + 4 * lh) * 2;
          const uint2 v0 = *(const uint2*)(vp);
          const uint2 v1 = *(const uint2*)(vp + 16);
          vf[kb][s2][vb] = (u32x4){v0.x, v0.y, v1.x, v1.y};
        }
    float mx = st[0][0];
#pragma unroll
    for (int i = 1; i < 16; ++i) mx = fmaxf(mx, st[0][i]);
#pragma unroll
    for (int i = 0; i < 16; ++i) mx = fmaxf(mx, st[1][i]);
    mx = fmaxf(mx, __shfl_xor(mx, 32));
    const float mn = fmaxf(m, mx);
    const float alpha = __builtin_amdgcn_exp2f(m - mn);
    m = mn;
    float ps = 0.f;
#pragma unroll
    for (int kb = 0; kb < 2; ++kb)
#pragma unroll
      for (int i = 0; i < 16; ++i) { st[kb][i] = __builtin_amdgcn_exp2f(st[kb][i] - mn); ps += st[kb][i]; }
    lsum = lsum * alpha + ps;
#pragma unroll
    for (int i = 0; i < 16; ++i) { O[0][i] *= alpha; O[1][i] *= alpha; }
#pragma unroll
    for (int kb = 0; kb < 2; ++kb)
#pragma unroll
      for (int s2 = 0; s2 < 2; ++s2) {
        u32x4 pk;
        pk.x = pack2(st[kb][8 * s2 + 0], st[kb][8 * s2 + 1]);
        pk.y = pack2(st[kb][8 * s2 + 2], st[kb][8 * s2 + 3]);
        pk.z = pack2(st[kb][8 * s2 + 4], st[kb][8 * s2 + 5]);
        pk.w = pack2(st[kb][8 * s2 + 6], st[kb][8 * s2 + 7]);
        const bf16x8 bfrag = __builtin_bit_cast(bf16x8, pk);
        O[0] = MFMA32(__builtin_bit_cast(bf16x8, vf[kb][s2][0]), bfrag, O[0]);
        O[1] = MFMA32(__builtin_bit_cast(bf16x8, vf[kb][s2][1]), bfrag, O[1]);
      }
    if (more) store_tiles((kt + 1) & 1);
    __syncthreads();
  }
  const float ltot = lsum + __shfl_xor(lsum, 32);
  const float inv = 1.f / ltot;
  u16* op = p.ACT + qrow * DM + hh * 64;
#pragma unroll
  for (int vb = 0; vb < 2; ++vb)
#pragma unroll
    for (int g = 0; g < 4; ++g) {
      uint2 o;
      o.x = pack2(O[vb][4 * g] * inv, O[vb][4 * g + 1] * inv);
      o.y = pack2(O[vb][4 * g + 2] * inv, O[vb][4 * g + 3] * inv);
      *(uint2*)(op + vb * 32 + 8 * g + 4 * lh) = o;
    }
}

DI void attn_tile8(const Params& p, int bh, int qt, char* smem) {
  const int b = bh >> 3, hh = bh & 7;
  const int nkt = (qt < 1) ? 2 : 34;
  const int tid = opq(threadIdx.x), lane = tid & 63, w = tid >> 6, lr = lane & 31, lh = lane >> 5;
  const size_t rowbase = (size_t)b * TPB;
  const size_t qrow = rowbase + qt * 256 + w * 32 + lr;
  constexpr int STAGE = 43520, VOFF = 26624, VROW = 264;
  bf16x8 qf[6];
  {
    const u16* qp = p.Q + qrow * 768 + hh * 96 + lh * 8;
#pragma unroll
    for (int s = 0; s < 6; ++s) qf[s] = *(const bf16x8*)(qp + 16 * s);
  }
  u32x4 rk[3], rv[2];
  auto load_tiles = [&](int kt) {
#pragma unroll
    for (int i = 0; i < 3; ++i) {
      const int idx = tid + 512 * i, key = idx / 12, ch = idx % 12;
      const size_t kr = rowbase + kt * 128 + key;
      rk[i] = (ch < 8) ? *(const u32x4*)(p.Kn + kr * 512 + hh * 64 + ch * 8) : *(const u32x4*)(p.KR + kr * 32 + (ch - 8) * 8);
    }
#pragma unroll
    for (int i = 0; i < 2; ++i) {
      const int idx = tid + 512 * i, vd = idx >> 4, ch = idx & 15;
      rv[i] = *(const u32x4*)(p.Vt + ((size_t)bh * 64 + vd) * TPB + kt * 128 + ch * 8);
    }
  };
  auto store_tiles = [&](int st) {
    char* Ks = smem + st * STAGE;
    char* Vs = Ks + VOFF;
#pragma unroll
    for (int i = 0; i < 3; ++i) {
      const int idx = tid + 512 * i, key = idx / 12, ch = idx % 12;
      *(u32x4*)(Ks + key * 208 + ch * 16) = rk[i];
    }
#pragma unroll
    for (int i = 0; i < 2; ++i) {
      const int idx = tid + 512 * i, vd = idx >> 4, ch = idx & 15;
      uint2* d = (uint2*)(Vs + vd * VROW + ch * 16);
      d[0] = make_uint2(rv[i].x, rv[i].y);
      d[1] = make_uint2(rv[i].z, rv[i].w);
    }
  };
  f32x16 O[2];
#pragma unroll
  for (int i = 0; i < 16; ++i) { O[0][i] = 0.f; O[1][i] = 0.f; }
  float m = -1e30f, lsum = 0.f;
  load_tiles(0);
  store_tiles(0);
  __syncthreads();
#pragma unroll 1
  for (int kt = 0; kt < nkt; ++kt) {
    const bool more = kt + 1 < nkt;
    if (more) load_tiles(kt + 1);
    const char* Ks = smem + (kt & 1) * STAGE;
    const char* Vs = Ks + VOFF;
    f32x16 st[4];
#pragma unroll
    for (int kb = 0; kb < 4; ++kb)
#pragma unroll
      for (int i = 0; i < 16; ++i) st[kb][i] = 0.f;
    {
      bf16x8 kf[2][4];
#pragma unroll
      for (int kb = 0; kb < 4; ++kb) kf[0][kb] = *(const bf16x8*)(Ks + (kb * 32 + lr) * 208 + lh * 16);
#pragma unroll
      for (int s = 0; s < 6; ++s) {
        if (s < 5) {
#pragma unroll
          for (int kb = 0; kb < 4; ++kb) kf[(s + 1) & 1][kb] = *(const bf16x8*)(Ks + (kb * 32 + lr) * 208 + (s + 1) * 32 + lh * 16);
        }
        __builtin_amdgcn_sched_barrier(0);
        __builtin_amdgcn_s_setprio(1);
#pragma unroll
        for (int kb = 0; kb < 4; ++kb) st[kb] = MFMA32(kf[s & 1][kb], qf[s], st[kb]);
        __builtin_amdgcn_s_setprio(0);
        __builtin_amdgcn_sched_barrier(0);
      }
    }
    u32x4 vfr[2][2];
#pragma unroll
    for (int vb = 0; vb < 2; ++vb) {
      const char* vp = Vs + (vb * 32 + lr) * VROW + (4 * lh) * 2;
      const uint2 v0 = *(const uint2*)(vp);
      const uint2 v1 = *(const uint2*)(vp + 16);
      vfr[0][vb] = (u32x4){v0.x, v0.y, v1.x, v1.y};
    }
    float mx = st[0][0];
#pragma unroll
    for (int kb = 0; kb < 4; ++kb)
#pragma unroll
      for (int i = 0; i < 16; ++i) mx = fmaxf(mx, st[kb][i]);
    mx = fmaxf(mx, __shfl_xor(mx, 32));
    const float mn = fmaxf(m, mx);
    const float alpha = __builtin_amdgcn_exp2f(m - mn);
    m = mn;
    float ps = 0.f;
#pragma unroll
    for (int kb = 0; kb < 4; ++kb)
#pragma unroll
      for (int i = 0; i < 16; ++i) { st[kb][i] = __builtin_amdgcn_exp2f(st[kb][i] - mn); ps += st[kb][i]; }
    lsum = lsum * alpha + ps;
#pragma unroll
    for (int i = 0; i < 16; ++i) { O[0][i] *= alpha; O[1][i] *= alpha; }
    {
#pragma unroll
      for (int step = 0; step < 8; ++step) {
        const int kb = step >> 1, s2 = step & 1;
        if (step < 7) {
          const int kb2 = (step + 1) >> 1, s22 = (step + 1) & 1;
#pragma unroll
          for (int vb = 0; vb < 2; ++vb) {
            const char* vp = Vs + (vb * 32 + lr) * VROW + (kb2 * 32 + 16 * s22 + 4 * lh) * 2;
            const uint2 v0 = *(const uint2*)(vp);
            const uint2 v1 = *(const uint2*)(vp + 16);
            vfr[(step + 1) & 1][vb] = (u32x4){v0.x, v0.y, v1.x, v1.y};
          }
        }
        u32x4 pk;
        pk.x = pack2(st[kb][8 * s2 + 0], st[kb][8 * s2 + 1]);
        pk.y = pack2(st[kb][8 * s2 + 2], st[kb][8 * s2 + 3]);
        pk.z = pack2(st[kb][8 * s2 + 4], st[kb][8 * s2 + 5]);
        pk.w = pack2(st[kb][8 * s2 + 6], st[kb][8 * s2 + 7]);
        const bf16x8 bfrag = __builtin_bit_cast(bf16x8, pk);
        __builtin_amdgcn_sched_barrier(0);
        O[0] = MFMA32(__builtin_bit_cast(bf16x8, vfr[step & 1][0]), bfrag, O[0]);
        O[1] = MFMA32(__builtin_bit_cast(bf16x8, vfr[step & 1][1]), bfrag, O[1]);
        __builtin_amdgcn_sched_barrier(0);
      }
    }
    if (more) store_tiles((kt + 1) & 1);
    __syncthreads();
  }
  const float ltot = lsum + __shfl_xor(lsum, 32);
  const float inv = 1.f / ltot;
  u16* op = p.ACT + qrow * DM + hh * 64;
#pragma unroll
  for (int vb = 0; vb < 2; ++vb)
#pragma unroll
    for (int g = 0; g < 4; ++g) {
      uint2 o;
      o.x = pack2(O[vb][4 * g] * inv, O[vb][4 * g + 1] * inv);
      o.y = pack2(O[vb][4 * g + 2] * inv, O[vb][4 * g + 3] * inv);
      *(uint2*)(op + vb * 32 + 8 * g + 4 * lh) = o;
    }
}

DI void final_tile(const Params& p, int t) {
  const int tid_ = opq(threadIdx.x & 255); const int lane = tid_ & 63, wid = tid_ >> 6;
  float4 G[4];
#pragma unroll
  for (int j = 0; j < 4; ++j) G[j] = *(const float4*)(p.final_g + lane * 4 + 256 * j);
  float* h0 = p.Hl + ((size_t)t * 32 + wid * 8) * DM;
#pragma unroll 1
  for (int rr = 0; rr < 8; rr += 2) {
    float4 v[2][4];
    float ss[2] = {0.f, 0.f};
#pragma unroll
    for (int u = 0; u < 2; ++u)
#pragma unroll
      for (int j = 0; j < 4; ++j) v[u][j] = *(const float4*)(h0 + (size_t)(rr + u) * DM + lane * 4 + 256 * j);
#pragma unroll
    for (int u = 0; u < 2; ++u)
#pragma unroll
      for (int j = 0; j < 4; ++j)
        ss[u] += v[u][j].x * v[u][j].x + v[u][j].y * v[u][j].y + v[u][j].z * v[u][j].z + v[u][j].w * v[u][j].w;
    ss[0] = wave_sum(ss[0]); ss[1] = wave_sum(ss[1]);
#pragma unroll
    for (int u = 0; u < 2; ++u) {
      const float r = rsqrtf(ss[u] * (1.f / DM) + 1e-6f);
#pragma unroll
      for (int j = 0; j < 4; ++j)
        *(float4*)(h0 + (size_t)(rr + u) * DM + lane * 4 + 256 * j) =
            make_float4(v[u][j].x * r * G[j].x, v[u][j].y * r * G[j].y, v[u][j].z * r * G[j].z, v[u][j].w * r * G[j].w);
    }
  }
}

#define XB_TMO      128
#define XB_XCNT(j)  (256  + 64 * (j))
#define XB_XSUB(j)  (1280 + 64 * (j))
#define XB_XGEN(j)  (2304 + 64 * (j))
#define XB_TOP      3328
#define XB_TOPGEN   3392
#define XCD_BAR_WORDS 3456
#define XB_SPIN_CAP (1u << 22)
#define LAS __attribute__((address_space(3)))
DI unsigned xb_ld(unsigned* p) { return __hip_atomic_load(p, __ATOMIC_RELAXED, __HIP_MEMORY_SCOPE_AGENT); }
DI unsigned xb_add(unsigned* p, unsigned v) { return __hip_atomic_fetch_add(p, v, __ATOMIC_RELAXED, __HIP_MEMORY_SCOPE_AGENT); }
DI unsigned xb_xcc_id() { return (unsigned)__builtin_amdgcn_s_getreg((3 << 11) | 20) & 0xFu; }
#define XB_SPIN(cond, bar) do { unsigned _sp = 0; while (cond) { __builtin_amdgcn_s_sleep(1); \
    if ((++_sp & 255u) == 0u) { if (xb_ld(&(bar)[XB_TMO])) break; if (_sp > XB_SPIN_CAP) { atomicAdd(&(bar)[XB_TMO], 1u); break; } } } } while (0)
struct XcdBarrier { unsigned* bar; unsigned x; volatile LAS unsigned* st; };
DI XcdBarrier xcd_barrier_post(unsigned* bar, volatile LAS unsigned* st) {
  XcdBarrier b; b.bar = bar; b.x = xb_xcc_id(); b.st = st;
  if (threadIdx.x == 0) (void)xb_add(&bar[XB_XCNT(b.x)], 1u);
  return b;
}
DI void xcd_barrier_complete(unsigned* bar, unsigned x, unsigned& nloc, unsigned& nx) {
  const unsigned G = gridDim.x * gridDim.y * gridDim.z;
  unsigned sum, cnt, mine, sp = 0u;
  for (;;) {
    sum = 0u; cnt = 0u; mine = 0u;
#pragma unroll
    for (unsigned j = 0; j < 16; ++j) { const unsigned c = xb_ld(&bar[XB_XCNT(j)]); sum += c; cnt += (c > 0u) ? 1u : 0u; mine = (j == x) ? c : mine; }
    if (sum == G) break;
    __builtin_amdgcn_s_sleep(1);
    if ((++sp & 255u) == 0u) { if (xb_ld(&bar[XB_TMO])) break; if (sp > XB_SPIN_CAP) { atomicAdd(&bar[XB_TMO], 1u); break; } }
  }
  nloc = mine > 0u ? mine : 1u; nx = cnt > 0u ? cnt : 1u;
}
DI void xcd_barrier(const XcdBarrier& b) {
  asm volatile("s_waitcnt vmcnt(0)" ::: "memory");
  __syncthreads();
  if (threadIdx.x == 0) {
    unsigned* bar = b.bar;
    __builtin_amdgcn_s_waitcnt(0);
    unsigned nloc = b.st[0], nx = b.st[1];
    if (nloc == 0u) { xcd_barrier_complete(bar, b.x, nloc, nx); b.st[0] = nloc; b.st[1] = nx; }
    const unsigned old = xb_add(&bar[XB_XSUB(b.x)], 1u);
    const unsigned gen = old / nloc;
    if (old + 1u == (gen + 1u) * nloc) {
      __builtin_amdgcn_fence(__ATOMIC_RELEASE, "agent");
      asm volatile("s_waitcnt vmcnt(0)" ::: "memory");
      const unsigned og = xb_add(&bar[XB_TOP], 1u);
      const unsigned tg = og / nx;
      if (og + 1u == (tg + 1u) * nx) xb_add(&bar[XB_TOPGEN], 1u);
      else XB_SPIN(xb_ld(&bar[XB_TOPGEN]) == tg, bar);
      __builtin_amdgcn_fence(__ATOMIC_ACQUIRE, "agent");
      xb_add(&bar[XB_XGEN(b.x)], 1u);
      asm volatile("s_waitcnt vmcnt(0)" ::: "memory");
    } else {
      XB_SPIN(xb_ld(&bar[XB_XGEN(b.x)]) == gen, bar);
      __builtin_amdgcn_fence(__ATOMIC_ACQUIRE, "agent");
      asm volatile("s_waitcnt vmcnt(0)" ::: "memory");
    }
  }
  __syncthreads();
}

__global__ void __launch_bounds__(256, 2) mega(Params p) {
  extern __shared__ __attribute__((aligned(16))) char smem[];
  cg::grid_group grid = cg::this_grid();
  const int bid = blockIdx.x, nb = gridDim.x;
  volatile LAS unsigned* xb_st = (volatile LAS unsigned*)(smem + SMEM_BYTES - 32);
  if (threadIdx.x < 2) xb_st[threadIdx.x] = 0u;
  if (bid == 0) for (int i = threadIdx.x; i < XCD_BAR_WORDS; i += 256) p.bar[i] = 0u;
  __syncthreads();

  {
    const size_t nx4 = (size_t)NB * SEQ * DM / 4, nc4 = (size_t)NB * CTXL * DM / 4;
    const float4* xs4 = (const float4*)p.x; float4* xd4 = (float4*)p.Hl;
    for (size_t i = (size_t)bid * 256 + threadIdx.x; i < nx4; i += (size_t)nb * 256) xd4[i] = xs4[i];
    const float4* cs4 = (const float4*)p.ctx; float4* cd4 = (float4*)p.Hc;
    for (size_t i = (size_t)bid * 256 + threadIdx.x; i < nc4; i += (size_t)nb * 256) cd4[i] = cs4[i];
  }
  for (int t = bid; t < DEPTH * WT_LAYER; t += nb) wconv_tile(p, t, smem);
  for (int t = bid; t < DEPTH * 96; t += nb) ada_tile(p, t, smem);
  if (bid == nb - 1) tables(p);
  if (bid == 0 && threadIdx.x < 8) p.ctr[threadIdx.x] = 0;
  grid.sync();
  const XcdBarrier xb = xcd_barrier_post(p.bar, xb_st);

#pragma unroll 1
  for (int l = 0; l < DEPTH; ++l) {
    const u16* Wl = p.W + (size_t)l * W_LAYER;
    for (int t = bid; t < MROWS / 32; t += nb) norm_tile(p, l, 0, t);
    xcd_barrier(xb);
    gemm_phase<EPI_P, false, true>(p, l, p.ACT, DM, Wl + W_IN, 1024, INP / 128, 0, smem, bid, nb);
    xcd_barrier(xb);
    for (int t = bid; t < MROWS / 32; t += nb) ssmprep_tile(p, l, t);
    gemm_phase<EPI_Q, true, false>(p, l, p.P, INP, Wl + W_Q, 384, 6, 0, smem, bid, nb);
    gemm_phase<EPI_KV, true, true>(p, l, p.P + 384, INP, Wl + W_KV, 256, 8, 0, smem, bid, nb);
    for (int t = bid; t < MT; t += nb) krope_tile(p, t);
    xcd_barrier(xb);
    if (bid < 128) hgrn_chain(p, l, bid, smem);
    else if (bid < 256) ssm_chain(p, l, bid - 128, smem);
    {
      volatile int* s_tile = (volatile int*)(smem + SMEM_BYTES - 16);
      for (;;) {
        __syncthreads();
        if (threadIdx.x == 0) *s_tile = atomicAdd(p.ctr + l, 1);
        __syncthreads();
        const int t = *s_tile;
        if (t >= NB * 8 * 34) break;
        if (t < NB * 8 * 32) attn_tile(p, t >> 5, 2 + (t & 31), smem);
        else attn_tile(p, (t - NB * 8 * 32) >> 1, t & 1, smem);
      }
    }
    xcd_barrier(xb);
    for (int t = bid; t < MROWS / 32; t += nb) readout_tile(p, l, t);
    xcd_barrier(xb);
    gemm_phase<EPI_RES, false, true>(p, l, p.ACT, DM, Wl + W_OUT, 1024, 8, 2048, smem, bid, nb);
    xcd_barrier(xb);
    for (int t = bid; t < MROWS / 32; t += nb) norm_tile(p, l, 1, t);
    xcd_barrier(xb);
    gemm_phase<EPI_SWIGLU, false, true>(p, l, p.ACT, DM, Wl + W_FI, 1024, 44, 0, smem, bid, nb);
    xcd_barrier(xb);
    gemm_phase<EPI_RES, false, true>(p, l, p.P, FFH, Wl + W_FO, FFH, 8, 5120, smem, bid, nb);
    xcd_barrier(xb);
  }
  for (int t = bid; t < NB * SEQ / 32; t += nb) final_tile(p, t);
}

constexpr size_t SMEM8 = 155648;
constexpr size_t HALF_LDS = 76800;

__global__ void __launch_bounds__(512, 2) mega8(Params p) {
  extern __shared__ __attribute__((aligned(16))) char smem[];
  cg::grid_group grid = cg::this_grid();
  const int bid = blockIdx.x, nb = gridDim.x;
  const int half = __builtin_amdgcn_readfirstlane(threadIdx.x >> 8);
  const int vb = 2 * bid + half, nvb = 2 * nb;
  char* hsm = smem + (size_t)half * HALF_LDS;
  volatile LAS unsigned* xb_st = (volatile LAS unsigned*)(smem + SMEM8 - 32);
  if (threadIdx.x < 2) xb_st[threadIdx.x] = 0u;
  if (bid == 0) for (int i = threadIdx.x; i < XCD_BAR_WORDS; i += 512) p.bar[i] = 0u;
  __syncthreads();

  for (int t = vb; t < DEPTH * WT_LAYER; t += nvb) wconv_tile(p, t, hsm);
  for (int t = vb; t < DEPTH * 96; t += nvb) ada_tile(p, t, hsm);
  if (bid == nb - 1) tables(p);
  if (bid == 0 && threadIdx.x < 8) p.ctr[threadIdx.x] = 0;
  grid.sync();
  const XcdBarrier xb = xcd_barrier_post(p.bar, xb_st);

#pragma unroll 1
  for (int l = 0; l < DEPTH; ++l) {
    const u16* Wl = p.W + (size_t)l * W_LAYER;
    const bool lastl = (l == DEPTH - 1);
    for (int t = vb; t < MROWS / 32; t += nvb) norm_tile(p, l, 0, t, l == 0);
    xcd_barrier(xb);
    gemm_phase8<EPI_P, false>(p, l, p.ACT, DM, Wl + W_IN, 1024, INP / 256, 0, smem);
    xcd_barrier(xb);
    for (int t = vb; t < MROWS / 32; t += nvb) ssmprep_tile(p, l, t);
    gemm_phase<EPI_Q, true, false>(p, l, p.P, INP, Wl + W_Q, 384, 6, 0, hsm, vb, nvb);
    gemm_phase8<EPI_KV, true>(p, l, p.P + 384, INP, Wl + W_KV, 256, 4, 0, smem);
    for (int t = vb; t < MT; t += nvb) krope_tile(p, t);
    xcd_barrier(xb);
    if (vb < 128) hgrn_chain(p, l, vb, hsm);
    else if (vb < 256) ssm_chain(p, l, vb - 128, hsm);
    {
      volatile int* s_tile = (volatile int*)(smem + SMEM8 - 16);
      for (;;) {
        __syncthreads();
        if (threadIdx.x == 0) *s_tile = atomicAdd(p.ctr + l, 1);
        __syncthreads();
        const int t = *s_tile;
        if (t >= (lastl ? NB * 8 * 16 : NB * 8 * 17)) break;
        if (t < NB * 8 * 16) attn_tile8(p, t >> 4, 1 + (t & 15), smem);
        else attn_tile8(p, t - NB * 8 * 16, 0, smem);
      }
    }
    xcd_barrier(xb);
    for (int t = vb; t < MROWS / 32; t += nvb) readout_tile(p, l, t);
    xcd_barrier(xb);
    gemm_phase8<EPI_RES, false>(p, l, p.ACT, DM, Wl + W_OUT, 1024, 4, 2048, smem, lastl);
    xcd_barrier(xb);
    for (int t = vb; t < MROWS / 32; t += nvb) if (!lastl || (t % (TPB / 32)) >= CTXL / 32) norm_tile(p, l, 1, t);
    xcd_barrier(xb);
    gemm_phase8<EPI_SWIGLU, false>(p, l, p.ACT, DM, Wl + W_FI, 1024, 22, 0, smem, lastl);
    xcd_barrier(xb);
    gemm_phase8<EPI_RES, false>(p, l, p.P, FFH, Wl + W_FO, FFH, 4, 5120, smem, lastl);
    xcd_barrier(xb);
  }
  for (int t = vb; t < NB * SEQ / 32; t += nvb) final_tile(p, t);
}

extern "C" void kernel_launch(void* const* d_in, const int* in_sizes, int n_in, void* d_out, int out_size, void* d_ws,
                              size_t ws_size, hipStream_t stream) {
  static int grid_blocks = 0;
  if (!grid_blocks) {
    hipFuncSetAttribute((const void*)mega8, hipFuncAttributeMaxDynamicSharedMemorySize, (int)SMEM8);
    int dev = 0, cus = 0, per_cu = 0;
    hipGetDevice(&dev);
    hipDeviceGetAttribute(&cus, hipDeviceAttributeMultiprocessorCount, dev);
    hipOccupancyMaxActiveBlocksPerMultiprocessor(&per_cu, mega8, 512, SMEM8);
    if (per_cu > 1) per_cu = 1;
    grid_blocks = cus * per_cu;
  }
  Params p{};
  const float* const* in = (const float* const*)d_in;
  p.x = in[0]; p.c = in[1]; p.ctx = in[2]; p.c_ctx = in[3]; p.w_ada = in[4]; p.b_ada = in[5]; p.norm1_g = in[6];
  p.norm2_g = in[7]; p.w_in = in[8]; p.qa_g = in[9]; p.wqb = in[10]; p.kva_g = in[11]; p.wkvb = in[12];
  p.lb_logits = in[13]; p.hg_norm_g = in[14]; p.conv_w = in[15]; p.conv_b = in[16]; p.dt_bias = in[17];
  p.a_log = in[18]; p.ssm_d = in[19]; p.ssm_norm_g = in[20]; p.w_out = in[21]; p.w_ffn_in = in[22];
  p.w_ffn_out = in[23]; p.final_g = in[24];
  p.Hl = (float*)d_out;
  char* ws = (char*)d_ws;
  size_t off = 0;
  auto take = [&](size_t bytes) { char* r = ws + off; off += (bytes + 255) & ~(size_t)255; return r; };
  p.W = (u16*)take((size_t)DEPTH * W_LAYER * 2);
  p.mod = (float*)take((size_t)DEPTH * 17 * 6144 * 4);
  p.rope = (float*)take(64 * 8 * 2 * 4);
  p.lbt = (float*)take(DEPTH * 2 * 256 * 4);
  p.Hc = (float*)take((size_t)NB * CTXL * DM * 4);
  p.ACT = (u16*)take((size_t)MROWS * DM * 2);
  p.P = (u16*)take((size_t)MROWS * INP * 2);
  p.Q = (u16*)take((size_t)MROWS * 768 * 2);
  p.Kn = (u16*)take((size_t)MROWS * 512 * 2);
  p.Vt = (u16*)take((size_t)MROWS * 512 * 2);
  p.KR = (u16*)take((size_t)MROWS * 32 * 2);
  p.RO = (u16*)take((size_t)MROWS * 512 * 2);
  p.RY = (u16*)take((size_t)MROWS * 512 * 2);
  p.ctr = (int*)take(256);
  p.DTA = (float*)take((size_t)MROWS * 16 * 4);
  p.bar = (unsigned*)take(XCD_BAR_WORDS * 4);
  if (off > ws_size) fprintf(stderr, "workspace too small: need %zu have %zu\n", off, ws_size);
  void* args[] = {&p};
  hipError_t e = hipLaunchCooperativeKernel((const void*)mega8, dim3(grid_blocks), dim3(512), args, SMEM8, stream);
  if (e != hipSuccess) fprintf(stderr, "cooperative launch failed: %s (grid %d)\n", hipGetErrorString(e), grid_blocks);
}
```

```cpp
#include <hip/hip_runtime.h>
#include <hip/hip_cooperative_groups.h>
#include <cstdio>
namespace cg = cooperative_groups;

typedef unsigned short u16;
using bf16x8 = __attribute__((ext_vector_type(8))) short;
using f32x16 = __attribute__((ext_vector_type(16))) float;
typedef __attribute__((ext_vector_type(2))) float f32x2;
using u32x4 = __attribute__((ext_vector_type(4))) unsigned;
typedef __attribute__((ext_vector_type(2))) __bf16 bf16x2;
#define DI __device__ __forceinline__
#define MFMA32(a, b, c) __builtin_amdgcn_mfma_f32_32x32x16_bf16((a), (b), (c), 0, 0, 0)

constexpr int DM = 1024, NB = 16, SEQ = 4096, CTXL = 256, TPB = 4352, MROWS = NB * TPB, DEPTH = 4;
constexpr int INC = 2728, INP = 2816, FFH = 2816;
constexpr int MT = MROWS / 128;
constexpr int O1 = 672, O2 = 1952;
constexpr float QSCALE = 0.10206207261596577f * 1.4426950408889634f;
constexpr size_t SMEM_BYTES = 76800;

constexpr size_t W_IN = 0;
constexpr size_t W_Q = W_IN + (size_t)INP * 1024;
constexpr size_t W_KV = W_Q + (size_t)768 * 384;
constexpr size_t W_OUT = W_KV + (size_t)1024 * 256;
constexpr size_t W_FI = W_OUT + (size_t)1024 * 1024;
constexpr size_t W_FO = W_FI + (size_t)5632 * 1024;
constexpr size_t W_LAYER = W_FO + (size_t)1024 * FFH;
constexpr int WT_IN = 44 * 16, WT_Q = 12 * 6, WT_KV = 16 * 4, WT_OUT = 16 * 16, WT_FI = 88 * 16, WT_FO = 16 * 44;
constexpr int WT_LAYER = WT_IN + WT_Q + WT_KV + WT_OUT + WT_FI + WT_FO;

struct Params {
  const float *x, *c, *ctx, *c_ctx, *w_ada, *b_ada, *norm1_g, *norm2_g, *w_in, *qa_g, *wqb, *kva_g, *wkvb, *lb_logits,
      *hg_norm_g, *conv_w, *conv_b, *dt_bias, *a_log, *ssm_d, *ssm_norm_g, *w_out, *w_ffn_in, *w_ffn_out, *final_g;
  float* Hl;
  u16* W;
  float* mod;
  float* rope;
  float* lbt;
  float* Hc;
  u16* ACT;
  u16* P;
  u16* Q;
  u16* Kn;
  u16* Vt;
  u16* KR;
  u16* RO;
  u16* RY;
  int* ctr;
  float* DTA;
  unsigned* bar;
};

DI float bf2f(u16 v) { return __uint_as_float((unsigned)v << 16); }
DI unsigned pack2(float a, float b) {
  f32x2 v = {a, b};
  return __builtin_bit_cast(unsigned, __builtin_convertvector(v, bf16x2));
}
DI u16 f2bf(float a) { return (u16)(pack2(a, 0.f) & 0xffffu); }
DI float lo2f(unsigned u) { return __uint_as_float(u << 16); }
DI float hi2f(unsigned u) { return __uint_as_float(u & 0xffff0000u); }
DI float sigmoidf(float x) { return __builtin_amdgcn_rcpf(1.f + __expf(-x)); }
DI float siluf(float x) { return x * __builtin_amdgcn_rcpf(1.f + __expf(-x)); }
DI int opq(int x) { asm volatile("" : "+v"(x)); return x; }
template <int N>
DI float dpp_row_shr(float x) {
  return __builtin_bit_cast(float, __builtin_amdgcn_update_dpp(0, __builtin_bit_cast(int, x), 0x110 + N, 0xf, 0xf, true));
}
template <int CTRL>
DI float dpp_f(float x) {
  return __builtin_bit_cast(float, __builtin_amdgcn_update_dpp(0, __builtin_bit_cast(int, x), CTRL, 0xf, 0xf, true));
}
DI float row_sum16(float x) {
  x += dpp_f<0xB1>(x); x += dpp_f<0x4E>(x); x += dpp_f<0x141>(x); x += dpp_f<0x140>(x);
  return x;
}
DI float rdlane(float x, int l) { return __builtin_bit_cast(float, __builtin_amdgcn_readlane(__builtin_bit_cast(int, x), l)); }
DI float wave_sum(float x) {
  x = row_sum16(x);
  return (rdlane(x, 0) + rdlane(x, 16)) + (rdlane(x, 32) + rdlane(x, 48));
}
DI int crow(int i, int h) { return (i & 3) + 8 * (i >> 2) + 4 * h; }
DI void unpack8(const u32x4 r, float* f) {
  f[0] = lo2f(r.x); f[1] = hi2f(r.x); f[2] = lo2f(r.y); f[3] = hi2f(r.y);
  f[4] = lo2f(r.z); f[5] = hi2f(r.z); f[6] = lo2f(r.w); f[7] = hi2f(r.w);
}

DI void wconv_tile(const Params& p, int t, char* smem) {
  const int l = t / WT_LAYER;
  int r = t % WT_LAYER;
  const float* src; const float* gk = nullptr; u16* dst; int K, Nsrc, ntn, kind;
  u16* Wl = p.W + (size_t)l * W_LAYER;
  if (r < WT_IN) { src = p.w_in + (size_t)l * 1024 * INC; dst = Wl + W_IN; K = 1024; Nsrc = INC; ntn = 44; kind = 0; }
  else if ((r -= WT_IN) < WT_Q) { src = p.wqb + (size_t)l * 384 * 768; dst = Wl + W_Q; K = 384; Nsrc = 768; ntn = 12; kind = 1; gk = p.qa_g + l * 384; }
  else if ((r -= WT_Q) < WT_KV) { src = p.wkvb + (size_t)l * 256 * 1024; dst = Wl + W_KV; K = 256; Nsrc = 1024; ntn = 16; kind = 1; gk = p.kva_g + l * 256; }
  else if ((r -= WT_KV) < WT_OUT) { src = p.w_out + (size_t)l * 1024 * 1024; dst = Wl + W_OUT; K = 1024; Nsrc = 1024; ntn = 16; kind = 1; }
  else if ((r -= WT_OUT) < WT_FI) { src = p.w_ffn_in + (size_t)l * 1024 * 5632; dst = Wl + W_FI; K = 1024; Nsrc = 5632; ntn = 88; kind = 2; }
  else { r -= WT_FI; src = p.w_ffn_out + (size_t)l * FFH * 1024; dst = Wl + W_FO; K = FFH; Nsrc = 1024; ntn = 16; kind = 1; }
  const int n0 = (r % ntn) * 64, k0 = (r / ntn) * 64;
  float* tile = (float*)smem;
  const int tid = opq(threadIdx.x & 255);
  {
    const int nn4 = (tid & 15) * 4, kk = tid >> 4;
    const int n = n0 + nn4;
    int sn; bool valid = true;
    if (kind == 2) { const int j = n >> 6, w = n & 63; sn = (w < 32) ? (32 * j + w) : (FFH + 32 * j + (w - 32)); }
    else { sn = n; if (kind == 0) valid = n < INC; }
#pragma unroll
    for (int i = 0; i < 4; ++i) {
      const int k = k0 + kk + 16 * i;
      float4 v = make_float4(0.f, 0.f, 0.f, 0.f);
      if (valid) v = *(const float4*)(src + (size_t)k * Nsrc + sn);
      if (gk) { const float g = gk[k]; v.x *= g; v.y *= g; v.z *= g; v.w *= g; }
      float* tp = tile + (kk + 16 * i) * 65 + nn4;
      tp[0] = v.x; tp[1] = v.y; tp[2] = v.z; tp[3] = v.w;
    }
  }
  __syncthreads();
  {
    const int nn = tid >> 2, kq = (tid & 3) * 16;
    unsigned o[8];
#pragma unroll
    for (int i = 0; i < 8; ++i) o[i] = pack2(tile[(kq + 2 * i) * 65 + nn], tile[(kq + 2 * i + 1) * 65 + nn]);
    uint4* d = (uint4*)(dst + (size_t)(n0 + nn) * K + k0 + kq);
    d[0] = make_uint4(o[0], o[1], o[2], o[3]);
    d[1] = make_uint4(o[4], o[5], o[6], o[7]);
  }
  __syncthreads();
}

DI void ada_tile(const Params& p, int t, char* smem) {
  const int l = t / 96, cb = (t % 96) * 64;
  float* sc = (float*)smem;
  const int tid = opq(threadIdx.x & 255);
  for (int i = tid; i < 17 * 1024; i += 256) {
    const int r = i >> 10, k = i & 1023;
    const float v = (r < 16) ? p.c[r * 1024 + k] : p.c_ctx[k];
    sc[i] = siluf(v);
  }
  __syncthreads();
  const int col = tid & 63, kq = tid >> 6;
  float acc[17];
#pragma unroll
  for (int r = 0; r < 17; ++r) acc[r] = 0.f;
  const float* wp = p.w_ada + ((size_t)l * 1024 + kq * 256) * 6144 + cb + col;
  for (int k = 0; k < 256; k += 4) {
    const float w0 = wp[(size_t)(k + 0) * 6144], w1 = wp[(size_t)(k + 1) * 6144], w2 = wp[(size_t)(k + 2) * 6144], w3 = wp[(size_t)(k + 3) * 6144];
#pragma unroll
    for (int r = 0; r < 17; ++r) {
      const float4 s = *(const float4*)(sc + r * 1024 + kq * 256 + k);
      acc[r] = fmaf(s.x, w0, fmaf(s.y, w1, fmaf(s.z, w2, fmaf(s.w, w3, acc[r]))));
    }
  }
  __syncthreads();
  float* red = (float*)smem;
#pragma unroll
  for (int r = 0; r < 17; ++r) red[(kq * 17 + r) * 64 + col] = acc[r];
  __syncthreads();
  for (int i = tid; i < 17 * 64; i += 256) {
    const int r = i >> 6, cc = i & 63;
    const float v = red[(0 * 17 + r) * 64 + cc] + red[(1 * 17 + r) * 64 + cc] + red[(2 * 17 + r) * 64 + cc] + red[(3 * 17 + r) * 64 + cc];
    p.mod[((size_t)l * 17 + r) * 6144 + cb + cc] = v + p.b_ada[l * 6144 + cb + cc];
  }
  __syncthreads();
}

DI void tables(const Params& p) {
  const int tid = opq(threadIdx.x);
  for (int i = tid; i < 512; i += 256) {
    const int pos = i >> 3, f = i & 7;
    const float inv = powf(10000.f, -(float)f / 8.f);
    const float ang = (float)pos * inv;
    p.rope[i * 2] = cosf(ang);
    p.rope[i * 2 + 1] = sinf(ang);
  }
  for (int i = tid; i < 512; i += 256) {
    float lg[4], mx = -1e30f;
#pragma unroll
    for (int l = 0; l < 4; ++l) { lg[l] = p.lb_logits[l * 512 + i]; mx = fmaxf(mx, lg[l]); }
    float s = 0.f;
#pragma unroll
    for (int l = 0; l < 4; ++l) { lg[l] = expf(lg[l] - mx); s += lg[l]; }
    float cum = 0.f;
#pragma unroll
    for (int l = 0; l < 4; ++l) { if (l > 0) cum += lg[l] / s; p.lbt[l * 512 + i] = cum; }
  }
}

DI const float* hrow_in(const Params& p, int row) {
  const int b = row / TPB, tt = row % TPB;
  if (tt < CTXL) return p.Hc + ((size_t)b * CTXL + tt) * DM;
  return p.Hl + ((size_t)b * SEQ + (tt - CTXL)) * DM;
}
DI void norm_tile(const Params& p, int l, int which, int t, bool first = false) {
  const int tid_ = opq(threadIdx.x & 255); const int lane = tid_ & 63, wid = tid_ >> 6;
  const float* ng = (which ? p.norm2_g : p.norm1_g) + l * DM;
  const int row0 = t * 32 + wid * 8;
  const int b = row0 / TPB, tt0 = row0 % TPB;
  const float* md = p.mod + ((size_t)l * 17 + (tt0 < CTXL ? 16 : b)) * 6144 + which * 3072;
  float4 G[4], SH[4];
#pragma unroll
  for (int j = 0; j < 4; ++j) {
    const int col = lane * 4 + 256 * j;
    const float4 g = *(const float4*)(ng + col);
    const float4 sc = *(const float4*)(md + 1024 + col);
    SH[j] = *(const float4*)(md + col);
    G[j] = make_float4(g.x * (1.f + sc.x), g.y * (1.f + sc.y), g.z * (1.f + sc.z), g.w * (1.f + sc.w));
  }
  float* hres = (float*)hrow_in(p, row0);
  const float* h0 = hres;
  if (first) h0 = (tt0 < CTXL) ? p.ctx + ((size_t)b * CTXL + tt0) * DM : p.x + ((size_t)b * SEQ + (tt0 - CTXL)) * DM;
#pragma unroll 1
  for (int rr = 0; rr < 8; rr += 2) {
    float4 v[2][4];
    float ss[2] = {0.f, 0.f};
#pragma unroll
    for (int u = 0; u < 2; ++u)
#pragma unroll
      for (int j = 0; j < 4; ++j) {
        v[u][j] = *(const float4*)(h0 + (size_t)(rr + u) * DM + lane * 4 + 256 * j);
        if (first) *(float4*)(hres + (size_t)(rr + u) * DM + lane * 4 + 256 * j) = v[u][j];
      }
#pragma unroll
    for (int u = 0; u < 2; ++u)
#pragma unroll
      for (int j = 0; j < 4; ++j)
        ss[u] += v[u][j].x * v[u][j].x + v[u][j].y * v[u][j].y + v[u][j].z * v[u][j].z + v[u][j].w * v[u][j].w;
    ss[0] = wave_sum(ss[0]); ss[1] = wave_sum(ss[1]);
#pragma unroll
    for (int u = 0; u < 2; ++u) {
      const float r = rsqrtf(ss[u] * (1.f / DM) + 1e-6f);
#pragma unroll
      for (int j = 0; j < 4; ++j) {
        uint2 o;
        o.x = pack2(v[u][j].x * r * G[j].x + SH[j].x, v[u][j].y * r * G[j].y + SH[j].y);
        o.y = pack2(v[u][j].z * r * G[j].z + SH[j].z, v[u][j].w * r * G[j].w + SH[j].w);
        *(uint2*)(p.ACT + (size_t)(row0 + rr + u) * DM + lane * 4 + 256 * j) = o;
      }
    }
  }
}

enum { EPI_P = 0, EPI_Q = 1, EPI_KV = 2, EPI_RES = 3, EPI_SWIGLU = 4 };

template <int EPI, int MB, int NWC>
DI void gemm_epi(const Params& p, int l, f32x16 (&acc)[MB][2], const float* rs, int mt, int nt, int gofs,
                 int wr, int wc, int lr, int lh) {
  lr = opq(lr); lh = opq(lh); wr = opq(wr);
  constexpr int TM = MB * 64, TN = NWC * 64, TPBT = TPB / TM, WRS = MB * 32;
  const int bidx = mt / TPBT, tt0 = (mt % TPBT) * TM;
  const bool isctx = tt0 < CTXL;
  if (EPI == EPI_P) {
#pragma unroll
    for (int nb = 0; nb < 2; ++nb) {
      const int cblk = nt * (NWC * 2) + wc * 2 + nb;
      const int col = cblk * 32 + lr;
      const int kind = (cblk >= 21 && cblk < 29) ? 1 : ((cblk >= 29 && cblk < 45) ? 2 : 0);
      float oml = 0.f;
      if (kind == 2) oml = 1.f - p.lbt[l * 512 + (col - 928)];
#pragma unroll
      for (int mb = 0; mb < MB; ++mb)
#pragma unroll
        for (int i = 0; i < 16; ++i) {
          const int row = mt * TM + wr * WRS + mb * 32 + crow(i, lh);
          float v = acc[mb][nb][i];
          if (kind == 1) v = siluf(v);
          else if (kind == 2) v = -oml * __builtin_amdgcn_rcpf(1.f + __expf(v));
          *(u16*)((char*)p.P + (unsigned)((row * INP + col) * 2)) = f2bf(v);
        }
    }
  } else if (EPI == EPI_Q) {
#pragma unroll
    for (int nb = 0; nb < 2; ++nb) {
      const int cblk = nt * (NWC * 2) + wc * 2 + nb;
      const bool ropeblk = (cblk % 3) == 2;
#pragma unroll
      for (int mb = 0; mb < MB; ++mb)
#pragma unroll
        for (int i = 0; i < 16; ++i) {
          const int rl = wr * WRS + mb * 32 + crow(i, lh);
          float v = acc[mb][nb][i] * rs[rl] * QSCALE;
          if (ropeblk && !isctx) {
            const float pv = dpp_f<0x128>(v);
            const int t = tt0 - CTXL + rl;
            const int pos = (lr & 16) ? (t & 63) : (t >> 6);
            const float2 cs = *(const float2*)(p.rope + (pos * 8 + (lr & 7)) * 2);
            v = (lr & 8) ? (v * cs.x + pv * cs.y) : (v * cs.x - pv * cs.y);
          }
          *(u16*)((char*)p.Q + (unsigned)(((mt * TM + rl) * 768 + cblk * 32 + lr) * 2)) = f2bf(v);
          if ((i & 7) == 7) __builtin_amdgcn_sched_barrier(0);
        }
    }
  } else if (EPI == EPI_KV) {
    const int head = (nt * NWC + wc) >> 1;
    if ((wc & 1) == 0) {
#pragma unroll
      for (int mb = 0; mb < MB; ++mb)
#pragma unroll
        for (int nb = 0; nb < 2; ++nb)
#pragma unroll
          for (int i = 0; i < 16; ++i) {
            const int rl = wr * WRS + mb * 32 + crow(i, lh);
            *(u16*)((char*)p.Kn + (unsigned)(((mt * TM + rl) * 512 + head * 64 + nb * 32 + lr) * 2)) = f2bf(acc[mb][nb][i] * rs[rl]);
          }
    } else {
#pragma unroll
      for (int mb = 0; mb < MB; ++mb)
#pragma unroll
        for (int nb = 0; nb < 2; ++nb)
#pragma unroll
          for (int g = 0; g < 4; ++g) {
            const int rl = wr * WRS + mb * 32 + 8 * g + 4 * lh;
            uint2 o;
            o.x = pack2(acc[mb][nb][4 * g] * rs[rl], acc[mb][nb][4 * g + 1] * rs[rl + 1]);
            o.y = pack2(acc[mb][nb][4 * g + 2] * rs[rl + 2], acc[mb][nb][4 * g + 3] * rs[rl + 3]);
            const int vd = nb * 32 + lr;
            *(uint2*)(p.Vt + ((size_t)(bidx * 8 + head) * 64 + vd) * TPB + tt0 + rl) = o;
          }
    }
  } else if (EPI == EPI_RES) {
    float* Hout = isctx ? p.Hc + ((size_t)bidx * CTXL + tt0) * DM : p.Hl + ((size_t)bidx * SEQ + tt0 - CTXL) * DM;
    const float* gate = p.mod + ((size_t)l * 17 + (isctx ? 16 : bidx)) * 6144 + gofs;
#pragma unroll
    for (int nb = 0; nb < 2; ++nb) {
      const int col = nt * TN + wc * 64 + nb * 32 + lr;
      const float gv = gate[col];
#pragma unroll
      for (int mb = 0; mb < MB; ++mb)
#pragma unroll
        for (int i = 0; i < 16; ++i) {
          const int rl = wr * WRS + mb * 32 + crow(i, lh);
          unsafeAtomicAdd((float*)((char*)Hout + (unsigned)((rl * DM + col) * 4)), gv * acc[mb][nb][i]);
          if ((i & 3) == 3) __builtin_amdgcn_sched_barrier(0);
        }
    }
  } else if (EPI == EPI_SWIGLU) {
#pragma unroll
    for (int mb = 0; mb < MB; ++mb)
#pragma unroll
      for (int i = 0; i < 16; ++i) {
        const int row = mt * TM + wr * WRS + mb * 32 + crow(i, lh);
        const float a = acc[mb][0][i], b = acc[mb][1][i];
        *(u16*)((char*)p.P + (unsigned)((row * FFH + (nt * NWC + wc) * 32 + lr) * 2)) = f2bf(siluf(a) * b);
      }
  }
}

template <int EPI, bool RSQ, bool DEEP>
DI void gemm_phase(const Params& p, int l, const u16* __restrict__ A, int lda, const u16* __restrict__ Bt, int K,
                   int ntiles_n, int gofs, char* smem, int vbid, int nvblk) {
  const int xcd = vbid & 7, lb = vbid >> 3, nlb = nvblk >> 3;
  constexpr int per = MT / 8;
  const int total = per * ntiles_n;
  auto decode = [&](int t, int& mt, int& nt) {
    const int grp = t / (8 * ntiles_n);
    const int rem = t - grp * 8 * ntiles_n;
    const int gsz = min(8, per - grp * 8);
    nt = rem / gsz;
    mt = per * xcd + grp * 8 + (rem - nt * gsz);
  };
  if (lb >= total) return;
  const int tid = opq(threadIdx.x & 255), lane = tid & 63, wid = tid >> 6, wr = wid >> 1, wc = wid & 1;
  const int lr = lane & 31, lh = lane >> 5;
  const int srow = tid >> 3, sch = tid & 7;
  const int nk = K >> 6;
  float* rs = (float*)(smem + 73728);
  int t = lb, mt, nt, kt = 0, cur = 0;
  decode(t, mt, nt);
  int Lt = lb, Lkt = 0;
  bool Lvalid = true;
  const u16* LA = A + (size_t)(mt * 128 + srow) * lda + sch * 8;
  const u16* LB = Bt + (size_t)(nt * 128 + srow) * K + sch * 8;
  auto issue = [&](u32x4 (&qa)[4], u32x4 (&qb)[4]) {
#pragma unroll
    for (int i = 0; i < 4; ++i) {
      qa[i] = *(const u32x4*)(LA + (size_t)(32 * i) * lda + Lkt * 64);
      qb[i] = *(const u32x4*)(LB + (size_t)(32 * i) * K + Lkt * 64);
    }
    if (++Lkt == nk) {
      Lkt = 0; Lt += nlb;
      if (Lt < total) {
        int a, b; decode(Lt, a, b);
        LA = A + (size_t)(a * 128 + srow) * lda + sch * 8;
        LB = Bt + (size_t)(b * 128 + srow) * K + sch * 8;
      } else Lvalid = false;
    }
  };
  float ssq[4] = {0.f, 0.f, 0.f, 0.f};
  auto stash = [&](u32x4 (&qa)[4], u32x4 (&qb)[4], int stage) {
    char* As = smem + stage * 36864;
    char* Bs = As + 18432;
#pragma unroll
    for (int i = 0; i < 4; ++i) {
      if (RSQ) { float f[8]; unpack8(qa[i], f);
#pragma unroll
        for (int e = 0; e < 8; ++e) ssq[i] = fmaf(f[e], f[e], ssq[i]); }
      *(u32x4*)(As + (srow + 32 * i) * 144 + sch * 16) = qa[i];
      *(u32x4*)(Bs + (srow + 32 * i) * 144 + sch * 16) = qb[i];
    }
  };
  auto stash_part = [&](u32x4 (&qa)[4], u32x4 (&qb)[4], int stage, int i) {
    char* As = smem + stage * 36864;
    char* Bs = As + 18432;
    if (RSQ) { float f[8]; unpack8(qa[i], f);
#pragma unroll
      for (int e = 0; e < 8; ++e) ssq[i] = fmaf(f[e], f[e], ssq[i]); }
    *(u32x4*)(As + (srow + 32 * i) * 144 + sch * 16) = qa[i];
    *(u32x4*)(Bs + (srow + 32 * i) * 144 + sch * 16) = qb[i];
  };
  u32x4 ra0[4], rb0[4], ra1[4], rb1[4];
  f32x16 acc[2][2];
#pragma unroll
  for (int a = 0; a < 2; ++a)
#pragma unroll
    for (int b = 0; b < 2; ++b)
#pragma unroll
      for (int i = 0; i < 16; ++i) acc[a][b][i] = 0.f;
  issue(ra0, rb0);
  bool v1 = DEEP && Lvalid;
  if (v1) issue(ra1, rb1);
  stash(ra0, rb0, 0);
  __syncthreads();
  auto body = [&](u32x4 (&La)[4], u32x4 (&Lb)[4], bool& Lset_valid, u32x4 (&Sa)[4], u32x4 (&Sb)[4], const bool& Sset_valid) -> bool {
    const bool last = (kt == nk - 1);
    Lset_valid = Lvalid;
    if (Lset_valid) issue(La, Lb);
    {
      const char* As = smem + cur * 36864;
      const char* Bs = As + 18432;
      const char* ap = As + (wr * 64 + lr) * 144 + lh * 16;
      const char* bp = Bs + (wc * 64 + lr) * 144 + lh * 16;
      bf16x8 fa[2][2], fb[2][2];
      fa[0][0] = *(const bf16x8*)(ap);
      fb[0][0] = *(const bf16x8*)(bp);
      fb[0][1] = *(const bf16x8*)(bp + 32 * 144);
      fa[0][1] = *(const bf16x8*)(ap + 32 * 144);
#pragma unroll
      for (int ks = 0; ks < 4; ++ks) {
        const int cu = ks & 1, nx = cu ^ 1;
        if (ks < 3) {
          fa[nx][0] = *(const bf16x8*)(ap + (ks + 1) * 32);
          fb[nx][0] = *(const bf16x8*)(bp + (ks + 1) * 32);
          fb[nx][1] = *(const bf16x8*)(bp + 32 * 144 + (ks + 1) * 32);
          fa[nx][1] = *(const bf16x8*)(ap + 32 * 144 + (ks + 1) * 32);
        }
        __builtin_amdgcn_sched_barrier(0);
        __builtin_amdgcn_s_setprio(1);
        acc[0][0] = MFMA32(fa[cu][0], fb[cu][0], acc[0][0]);
        acc[0][1] = MFMA32(fa[cu][0], fb[cu][1], acc[0][1]);
        acc[1][0] = MFMA32(fa[cu][1], fb[cu][0], acc[1][0]);
        acc[1][1] = MFMA32(fa[cu][1], fb[cu][1], acc[1][1]);
        __builtin_amdgcn_s_setprio(0);
        __builtin_amdgcn_sched_barrier(0);
      }
    }
    if (last) {
      if (RSQ) {
#pragma unroll
        for (int i = 0; i < 4; ++i) {
          float v = ssq[i];
          v += dpp_f<0xB1>(v); v += dpp_f<0x4E>(v); v += dpp_f<0x141>(v);
          if (sch == 0) rs[srow + 32 * i] = rsqrtf(v / (float)K + 1e-6f);
          ssq[i] = 0.f;
        }
        __syncthreads();
      }
      gemm_epi<EPI, 2, 2>(p, l, acc, rs, mt, nt, gofs, wr, wc, lr, lh);
#pragma unroll
      for (int a = 0; a < 2; ++a)
#pragma unroll
        for (int b = 0; b < 2; ++b)
#pragma unroll
          for (int i = 0; i < 16; ++i) acc[a][b][i] = 0.f;
    }
    if (Sset_valid) stash(Sa, Sb, cur ^ 1);
    __syncthreads();
    cur ^= 1;
    if (last) {
      t += nlb;
      if (t >= total) return false;
      decode(t, mt, nt);
      kt = 0;
    } else {
      ++kt;
    }
    return true;
  };
  bool v0 = false;
#pragma unroll 1
  for (;;) {
    if (DEEP) {
      if (!body(ra0, rb0, v0, ra1, rb1, v1)) break;
      if (!body(ra1, rb1, v1, ra0, rb0, v0)) break;
    } else {
      if (!body(ra0, rb0, v0, ra0, rb0, v0)) break;
    }
  }
}

template <int EPI, bool RSQ>
DI void gemm_phase8(const Params& p, int l, const u16* __restrict__ A, int lda, const u16* __restrict__ Bt, int K,
                   int ntiles_n, int gofs, char* smem, bool latonly = false) {
  const int xcd = blockIdx.x & 7, lb = blockIdx.x >> 3, nlb = gridDim.x >> 3;
  constexpr bool DEEP = false;
  constexpr int perfull = (MROWS / 256) / 8;
  const int per = latonly ? 32 : perfull;
  const int total = per * ntiles_n;
  auto decode = [&](int t, int& mt, int& nt) {
    const int grp = t / (8 * ntiles_n);
    const int rem = t - grp * 8 * ntiles_n;
    const int gsz = min(8, per - grp * 8);
    nt = rem / gsz;
    const int m = grp * 8 + (rem - nt * gsz);
    mt = perfull * xcd + (latonly ? (m >> 4) * 17 + 1 + (m & 15) : m);
  };
  if (lb >= total) return;
  const int tid = opq(threadIdx.x), lane = tid & 63, wid = tid >> 6, wr = wid >> 2, wc = wid & 3;
  const int lr = lane & 31, lh = lane >> 5;
  const int srow = tid >> 3, sch = tid & 7;
  const int nk = K >> 6;
  float* rs = (float*)(smem + 147456);
  int t = lb, mt, nt, kt = 0, cur = 0;
  decode(t, mt, nt);
  int Lt = lb, Lkt = 0;
  bool Lvalid = true;
  unsigned LAo = (unsigned)((mt * 256 + srow) * lda + sch * 8) * 2u;
  unsigned LBo = (unsigned)((nt * 256 + srow) * K + sch * 8) * 2u;
  const unsigned strideA = (unsigned)(64 * lda) * 2u, strideB = (unsigned)(64 * K) * 2u;
  auto issue = [&](u32x4 (&qa)[4], u32x4 (&qb)[4]) {
#pragma unroll
    for (int i = 0; i < 4; ++i) {
      qa[i] = *(const u32x4*)((const char*)A + (LAo + i * strideA + (unsigned)Lkt * 128u));
      qb[i] = *(const u32x4*)((const char*)Bt + (LBo + i * strideB + (unsigned)Lkt * 128u));
    }
    if (++Lkt == nk) {
      Lkt = 0; Lt += nlb;
      if (Lt < total) {
        int a, b; decode(Lt, a, b);
        LAo = (unsigned)((a * 256 + srow) * lda + sch * 8) * 2u;
        LBo = (unsigned)((b * 256 + srow) * K + sch * 8) * 2u;
      } else Lvalid = false;
    }
  };
  float ssq[4] = {0.f, 0.f, 0.f, 0.f};
  auto stash = [&](u32x4 (&qa)[4], u32x4 (&qb)[4], int stage) {
    char* As = smem + stage * 73728;
    char* Bs = As + 36864;
#pragma unroll
    for (int i = 0; i < 4; ++i) {
      if (RSQ) { float f[8]; unpack8(qa[i], f);
#pragma unroll
        for (int e = 0; e < 8; ++e) ssq[i] = fmaf(f[e], f[e], ssq[i]); }
      *(u32x4*)(As + (srow + 64 * i) * 144 + sch * 16) = qa[i];
      *(u32x4*)(Bs + (srow + 64 * i) * 144 + sch * 16) = qb[i];
    }
  };
  auto stash_part = [&](u32x4 (&qa)[4], u32x4 (&qb)[4], int stage, int i) {
    char* As = smem + stage * 73728;
    char* Bs = As + 36864;
    if (RSQ) { float f[8]; unpack8(qa[i], f);
#pragma unroll
      for (int e = 0; e < 8; ++e) ssq[i] = fmaf(f[e], f[e], ssq[i]); }
    *(u32x4*)(As + (srow + 64 * i) * 144 + sch * 16) = qa[i];
    *(u32x4*)(Bs + (srow + 64 * i) * 144 + sch * 16) = qb[i];
  };
  u32x4 ra0[4], rb0[4], ra1[4], rb1[4];
  f32x16 acc[4][2];
#pragma unroll
  for (int a = 0; a < 4; ++a)
#pragma unroll
    for (int b = 0; b < 2; ++b)
#pragma unroll
      for (int i = 0; i < 16; ++i) acc[a][b][i] = 0.f;
  issue(ra0, rb0);
  bool v1 = DEEP && Lvalid;
  if (v1) issue(ra1, rb1);
  stash(ra0, rb0, 0);
  __syncthreads();
  auto body = [&](u32x4 (&La)[4], u32x4 (&Lb)[4], bool& Lset_valid, u32x4 (&Sa)[4], u32x4 (&Sb)[4], const bool& Sset_valid) -> bool {
    const bool last = (kt == nk - 1);
    Lset_valid = Lvalid;
    {
      const char* As = smem + cur * 73728;
      const char* Bs = As + 36864;
      const char* ap = As + (wr * 128 + lr) * 144 + lh * 16;
      const char* bp = Bs + (wc * 64 + lr) * 144 + lh * 16;
      bf16x8 fa[3][2], fb[2][2];
      fa[0][0] = *(const bf16x8*)(ap);
      fa[0][1] = *(const bf16x8*)(ap + 32 * 144);
      fb[0][0] = *(const bf16x8*)(bp);
      fb[0][1] = *(const bf16x8*)(bp + 32 * 144);
      fa[1][0] = *(const bf16x8*)(ap + 2 * 32 * 144);
      fa[1][1] = *(const bf16x8*)(ap + 3 * 32 * 144);
      fb[1][0] = *(const bf16x8*)(bp + 32);
      fb[1][1] = *(const bf16x8*)(bp + 32 * 144 + 32);
      __builtin_amdgcn_sched_barrier(0);
      if (Lset_valid) issue(La, Lb);
      __builtin_amdgcn_sched_barrier(0);
#pragma unroll
      for (int u = 0; u < 8; ++u) {
        const int ks = u >> 1, hf = u & 1, ca = u % 3, cb = ks & 1;
        if (u + 2 < 8) {
          const int ks2 = (u + 2) >> 1, hf2 = (u + 2) & 1, cn = (u + 2) % 3;
          fa[cn][0] = *(const bf16x8*)(ap + (2 * hf2) * 32 * 144 + ks2 * 32);
          fa[cn][1] = *(const bf16x8*)(ap + (2 * hf2 + 1) * 32 * 144 + ks2 * 32);
        }
        __builtin_amdgcn_sched_barrier(0);
        __builtin_amdgcn_s_setprio(1);
        acc[2 * hf][0] = MFMA32(fa[ca][0], fb[cb][0], acc[2 * hf][0]);
        acc[2 * hf][1] = MFMA32(fa[ca][0], fb[cb][1], acc[2 * hf][1]);
        acc[2 * hf + 1][0] = MFMA32(fa[ca][1], fb[cb][0], acc[2 * hf + 1][0]);
        acc[2 * hf + 1][1] = MFMA32(fa[ca][1], fb[cb][1], acc[2 * hf + 1][1]);
        __builtin_amdgcn_s_setprio(0);
        __builtin_amdgcn_sched_barrier(0);
        if (hf == 1 && ks + 2 < 4) {
          fb[cb][0] = *(const bf16x8*)(bp + (ks + 2) * 32);
          fb[cb][1] = *(const bf16x8*)(bp + 32 * 144 + (ks + 2) * 32);
          __builtin_amdgcn_sched_barrier(0);
        }
      }
    }
    if (last) {
      if (RSQ) {
#pragma unroll
        for (int i = 0; i < 4; ++i) {
          float v = ssq[i];
          v += dpp_f<0xB1>(v); v += dpp_f<0x4E>(v); v += dpp_f<0x141>(v);
          if (sch == 0) rs[srow + 64 * i] = rsqrtf(v / (float)K + 1e-6f);
          ssq[i] = 0.f;
        }
        __syncthreads();
      }
      gemm_epi<EPI, 4, 4>(p, l, acc, rs, mt, nt, gofs, wr, wc, lr, lh);
#pragma unroll
      for (int a = 0; a < 4; ++a)
#pragma unroll
        for (int b = 0; b < 2; ++b)
#pragma unroll
          for (int i = 0; i < 16; ++i) acc[a][b][i] = 0.f;
    }
    if (Sset_valid) stash(Sa, Sb, cur ^ 1);
    __syncthreads();
    cur ^= 1;
    if (last) {
      t += nlb;
      if (t >= total) return false;
      decode(t, mt, nt);
      kt = 0;
    } else {
      ++kt;
    }
    return true;
  };
  bool v0 = false;
#pragma unroll 1
  for (;;) {
    if (DEEP) {
      if (!body(ra0, rb0, v0, ra1, rb1, v1)) break;
      if (!body(ra1, rb1, v1, ra0, rb0, v0)) break;
    } else {
      if (!body(ra0, rb0, v0, ra0, rb0, v0)) break;
    }
  }
}

DI void krope_tile(const Params& p, int t) {
  const int tid = opq(threadIdx.x & 255);
  const int sub = tid & 15, axis = sub >> 3, f = sub & 7;
#pragma unroll 1
  for (int it = 0; it < 8; ++it) {
    const int row = t * 128 + it * 16 + (tid >> 4);
    const int tt = row % TPB;
    const u16* src = p.P + (size_t)row * INP + 640 + axis * 16 + f;
    float x1 = bf2f(src[0]), x2 = bf2f(src[8]);
    if (tt >= CTXL) {
      const int tl = tt - CTXL;
      const int pos = axis ? (tl & 63) : (tl >> 6);
      const float2 cs = *(const float2*)(p.rope + (pos * 8 + f) * 2);
      const float y1 = x1 * cs.x - x2 * cs.y, y2 = x2 * cs.x + x1 * cs.y;
      x1 = y1; x2 = y2;
    }
    u16* dst = p.KR + (size_t)row * 32 + axis * 16 + f;
    dst[0] = f2bf(x1); dst[8] = f2bf(x2);
  }
}

DI void hgrn_chain(const Params& p, int l, int cid, char* smem) {
  const int b = cid >> 3, hh = (cid >> 1) & 3, dir = cid & 1;
  const int tid = opq(threadIdx.x & 255), lane = tid & 63, w = tid >> 6, lr = lane & 31, lh = lane >> 5;
  const int pb = w >> 1, jb = w & 1;
  float* bm = (float*)smem;
  float* tot = bm + 4096;
  float* er = tot + 256;
  float* ed = er + 64;
  char* Qd = (char*)(ed + 64);
  char* Kd = Qd + 9216;
  char* Kt = Kd + 9216;
  char* Vt = Kt + 9216;
  const size_t rowbase = (size_t)b * TPB;
  auto ttlo_of = [&](int c) { return dir ? (c < 4 ? 192 - 64 * c : 4544 - 64 * c) : 64 * c; };
  const int r = tid >> 2, q4 = tid & 3;
  const int jst = dir ? 63 - r : r;
  u32x4 rq[2], rn[2], rv[2];
  auto load_regs = [&](int c) {
    const u16* src = p.P + (rowbase + ttlo_of(c) + r) * INP + O1 + hh * 64 + q4 * 16;
    rq[0] = *(const u32x4*)(src); rq[1] = *(const u32x4*)(src + 8);
    rn[0] = *(const u32x4*)(src + 256 + dir * 256); rn[1] = *(const u32x4*)(src + 256 + dir * 256 + 8);
    rv[0] = *(const u32x4*)(src + 768); rv[1] = *(const u32x4*)(src + 768 + 8);
  };
  f32x16 Sacc[2];
#pragma unroll
  for (int i = 0; i < 16; ++i) { Sacc[0][i] = 0.f; Sacc[1][i] = 0.f; }
  load_regs(0);
  constexpr int NCH = TPB / 64;
#pragma unroll 1
  for (int c = 0; c < NCH; ++c) {
    const int tl = ttlo_of(c);
    float qv[16], kv[16];
    {
      float nk[16], vv[16];
      unpack8(rq[0], qv); unpack8(rq[1], qv + 8);
      unpack8(rn[0], nk); unpack8(rn[1], nk + 8);
      unpack8(rv[0], vv); unpack8(rv[1], vv + 8);
      float g[16];
#pragma unroll
      for (int e = 0; e < 16; ++e) { kv[e] = -nk[e]; g[e] = __logf(fmaxf(1.f + nk[e], 2e-9f)); }
      float* gd = bm + jst * 64 + q4 * 16;
#pragma unroll
      for (int e4 = 0; e4 < 4; ++e4) *(float4*)(gd + 4 * e4) = make_float4(g[4 * e4], g[4 * e4 + 1], g[4 * e4 + 2], g[4 * e4 + 3]);
#pragma unroll
      for (int e = 0; e < 16; ++e) *(u16*)(Vt + (q4 * 16 + e) * 144 + jst * 2) = f2bf(vv[e]);
    }
    if (c + 1 < NCH) load_regs(c + 1);
    __syncthreads();
    {
      const int kc = tid & 63, qt = tid >> 6;
      float loc[16];
#pragma unroll
      for (int i = 0; i < 16; ++i) loc[i] = bm[(16 * qt + i) * 64 + kc];
#pragma unroll
      for (int i = 1; i < 16; ++i) loc[i] += loc[i - 1];
      tot[qt * 64 + kc] = loc[15];
      __syncthreads();
      float off = 0.f;
#pragma unroll
      for (int q = 0; q < 3; ++q) if (q < qt) off += tot[q * 64 + kc];
#pragma unroll
      for (int i = 0; i < 16; ++i) bm[(16 * qt + i) * 64 + kc] = loc[i] + off;
    }
    __syncthreads();
    {
      const float* bj = bm + jst * 64 + q4 * 16;
      const float* br = bm + 31 * 64 + q4 * 16;
      unsigned qo[8], ko[8];
      float qdv[16], kd[16];
#pragma unroll
      for (int e = 0; e < 16; ++e) {
        const float d = bj[e] - br[e];
        qdv[e] = qv[e] * __expf(d);
        kd[e] = kv[e] * __expf(-d);
      }
#pragma unroll
      for (int e = 0; e < 8; ++e) { qo[e] = pack2(qdv[2 * e], qdv[2 * e + 1]); ko[e] = pack2(kd[2 * e], kd[2 * e + 1]); }
      *(u32x4*)(Qd + jst * 144 + q4 * 32) = (u32x4){qo[0], qo[1], qo[2], qo[3]};
      *(u32x4*)(Qd + jst * 144 + q4 * 32 + 16) = (u32x4){qo[4], qo[5], qo[6], qo[7]};
      *(u32x4*)(Kd + jst * 144 + q4 * 32) = (u32x4){ko[0], ko[1], ko[2], ko[3]};
      *(u32x4*)(Kd + jst * 144 + q4 * 32 + 16) = (u32x4){ko[4], ko[5], ko[6], ko[7]};
#pragma unroll
      for (int e = 0; e < 16; ++e) *(u16*)(Kt + (q4 * 16 + e) * 144 + jst * 2) = f2bf(kd[e]);
      if (tid < 64) {
        const float r31 = bm[31 * 64 + tid];
        er[tid] = __expf(r31);
        ed[tid] = __expf(bm[63 * 64 + tid] - r31);
      }
    }
    __syncthreads();
    {
      const int jg = 32 * jb + lr;
      bf16x8 qfr[4];
#pragma unroll
      for (int ks = 0; ks < 4; ++ks) qfr[ks] = *(const bf16x8*)(Qd + jg * 144 + ks * 32 + lh * 16);
      f32x16 st[2];
#pragma unroll
      for (int i = 0; i < 16; ++i) { st[0][i] = 0.f; st[1][i] = 0.f; }
#pragma unroll
      for (int sb = 0; sb < 2; ++sb)
#pragma unroll
        for (int ks = 0; ks < 4; ++ks) {
          const bf16x8 kfr = *(const bf16x8*)(Kd + (32 * sb + lr) * 144 + ks * 32 + lh * 16);
          st[sb] = MFMA32(kfr, qfr[ks], st[sb]);
        }
      f32x16 acc;
#pragma unroll
      for (int i = 0; i < 16; ++i) acc[i] = 0.f;
#pragma unroll
      for (int nb = 0; nb < 2; ++nb) {
#pragma unroll
        for (int g = 0; g < 4; ++g) {
          const float4 e4 = *(const float4*)(er + 32 * nb + 8 * g + 4 * lh);
          Sacc[nb][4 * g] *= e4.x; Sacc[nb][4 * g + 1] *= e4.y; Sacc[nb][4 * g + 2] *= e4.z; Sacc[nb][4 * g + 3] *= e4.w;
        }
#pragma unroll
        for (int s2 = 0; s2 < 2; ++s2) {
          u32x4 pk;
          pk.x = pack2(Sacc[nb][8 * s2 + 0], Sacc[nb][8 * s2 + 1]);
          pk.y = pack2(Sacc[nb][8 * s2 + 2], Sacc[nb][8 * s2 + 3]);
          pk.z = pack2(Sacc[nb][8 * s2 + 4], Sacc[nb][8 * s2 + 5]);
          pk.w = pack2(Sacc[nb][8 * s2 + 6], Sacc[nb][8 * s2 + 7]);
          const char* cp = Qd + jg * 144 + (32 * nb + 16 * s2 + 4 * lh) * 2;
          const uint2 c0 = *(const uint2*)(cp);
          const uint2 c1 = *(const uint2*)(cp + 16);
          const bf16x8 qperm = __builtin_bit_cast(bf16x8, ((u32x4){c0.x, c0.y, c1.x, c1.y}));
          acc = MFMA32(__builtin_bit_cast(bf16x8, pk), qperm, acc);
        }
      }
#pragma unroll
      for (int sb = 0; sb < 2; ++sb) {
#pragma unroll
        for (int i = 0; i < 16; ++i) {
          const int sg = 32 * sb + crow(i, lh);
          st[sb][i] = (sg <= jg) ? st[sb][i] : 0.f;
        }
#pragma unroll
        for (int s2 = 0; s2 < 2; ++s2) {
          u32x4 pk;
          pk.x = pack2(st[sb][8 * s2 + 0], st[sb][8 * s2 + 1]);
          pk.y = pack2(st[sb][8 * s2 + 2], st[sb][8 * s2 + 3]);
          pk.z = pack2(st[sb][8 * s2 + 4], st[sb][8 * s2 + 5]);
          pk.w = pack2(st[sb][8 * s2 + 6], st[sb][8 * s2 + 7]);
          const char* xp = Vt + (32 * pb + lr) * 144 + (32 * sb + 16 * s2 + 4 * lh) * 2;
          const uint2 x0 = *(const uint2*)(xp);
          const uint2 x1 = *(const uint2*)(xp + 16);
          const bf16x8 vfr = __builtin_bit_cast(bf16x8, ((u32x4){x0.x, x0.y, x1.x, x1.y}));
          acc = MFMA32(vfr, __builtin_bit_cast(bf16x8, pk), acc);
        }
      }
      {
        const int tt = dir ? tl + 63 - jg : tl + jg;
        u16* op = p.RO + (rowbase + tt) * 512 + dir * 256 + hh * 64 + 32 * pb + 4 * lh;
#pragma unroll
        for (int g = 0; g < 4; ++g) {
          uint2 o;
          o.x = pack2(acc[4 * g], acc[4 * g + 1]);
          o.y = pack2(acc[4 * g + 2], acc[4 * g + 3]);
          *(uint2*)(op + 8 * g) = o;
        }
      }
#pragma unroll
      for (int nb = 0; nb < 2; ++nb) {
#pragma unroll
        for (int ks = 0; ks < 4; ++ks) {
          const bf16x8 afr = *(const bf16x8*)(Kt + (32 * nb + lr) * 144 + ks * 32 + lh * 16);
          const bf16x8 bfr = *(const bf16x8*)(Vt + (32 * pb + lr) * 144 + ks * 32 + lh * 16);
          Sacc[nb] = MFMA32(afr, bfr, Sacc[nb]);
        }
#pragma unroll
        for (int g = 0; g < 4; ++g) {
          const float4 e4 = *(const float4*)(ed + 32 * nb + 8 * g + 4 * lh);
          Sacc[nb][4 * g] *= e4.x; Sacc[nb][4 * g + 1] *= e4.y; Sacc[nb][4 * g + 2] *= e4.z; Sacc[nb][4 * g + 3] *= e4.w;
        }
      }
    }
    __syncthreads();
  }
}

DI void ssmprep_tile(const Params& p, int l, int t) {
  const int tid_ = opq(threadIdx.x & 255); const int lane = tid_ & 63, wid = tid_ >> 6;
  const int c8 = lane * 8;
  float cw[5][8], cb[8];
#pragma unroll
  for (int e = 0; e < 8; ++e) {
    cb[e] = p.conv_b[l * 512 + c8 + e];
#pragma unroll
    for (int j = 0; j < 5; ++j) cw[j][e] = p.conv_w[((size_t)l * 5 + j) * 512 + c8 + e];
  }
  const int dcol = (c8 < 256) ? 768 + c8 : ((c8 < 384) ? 512 + (c8 - 256) : 640 + (c8 - 384));
  float dtb = 0.f, An = 0.f;
  if (lane < 8) { dtb = p.dt_bias[l * 8 + lane]; An = -expf(p.a_log[l * 8 + lane]); }
#pragma unroll 2
  for (int rr = 0; rr < 8; ++rr) {
    const int row = t * 32 + wid * 8 + rr;
    const int tt = row % TPB;
    const int seglo = (tt < CTXL) ? 0 : CTXL, seghi = (tt < CTXL) ? CTXL : TPB;
    const u16* Pr = p.P + (size_t)row * INP + O2 + 256 + c8;
    float a[8];
#pragma unroll
    for (int e = 0; e < 8; ++e) a[e] = cb[e];
#pragma unroll
    for (int j = 0; j < 5; ++j) {
      const int t2 = tt + j - 2;
      if (t2 >= seglo && t2 < seghi) {
        const u32x4 u = *(const u32x4*)(Pr + (ptrdiff_t)(j - 2) * INP);
        float f[8]; unpack8(u, f);
#pragma unroll
        for (int e = 0; e < 8; ++e) a[e] = fmaf(cw[j][e], f[e], a[e]);
      }
    }
    uint4 ov;
    ov.x = pack2(siluf(a[0]), siluf(a[1])); ov.y = pack2(siluf(a[2]), siluf(a[3]));
    ov.z = pack2(siluf(a[4]), siluf(a[5])); ov.w = pack2(siluf(a[6]), siluf(a[7]));
    *(uint4*)(p.ACT + (size_t)row * DM + dcol) = ov;
    if (lane < 8) {
      const float dr = bf2f(p.P[(size_t)row * INP + O2 + 768 + lane]) + dtb;
      const float dt = (dr > 20.f) ? dr : log1pf(expf(dr));
      p.DTA[(size_t)row * 16 + lane] = dt;
      p.DTA[(size_t)row * 16 + 8 + lane] = An * dt;
    }
  }
}

DI void ssm_chain(const Params& p, int l, int cid, char* smem) {
  const int b = cid >> 3, hh = (cid >> 1) & 3, dir = cid & 1, grp = hh >> 1;
  const int tid = opq(threadIdx.x & 255), lane = tid & 63, w = tid >> 6, lr = lane & 31, lh = lane >> 5;
  const int pb = w >> 1, jb = w & 1;
  char* Cq = smem;
  char* Bk = Cq + 9216;
  char* Btr = Bk + 9216;
  char* XT = Btr + 9216;
  char* XTs = XT + 8704;
  float* csm = (float*)(XTs + 9216);
  const size_t rowbase = (size_t)b * TPB;
  auto ttlo_of = [&](int c) { return dir ? (c < 4 ? 192 - 64 * c : 4544 - 64 * c) : 64 * c; };
  const int r = tid >> 2, q4 = tid & 3;
  const int jst = dir ? 63 - r : r;
  u32x4 rx[2], rB[2], rC[2];
  float rdt;
  auto load_regs = [&](int c) {
    const size_t row = rowbase + ttlo_of(c) + r;
    const u16* src = p.ACT + row * DM;
    rx[0] = *(const u32x4*)(src + 768 + hh * 64 + q4 * 16); rx[1] = *(const u32x4*)(src + 768 + hh * 64 + q4 * 16 + 8);
    rB[0] = *(const u32x4*)(src + 512 + grp * 64 + q4 * 16); rB[1] = *(const u32x4*)(src + 512 + grp * 64 + q4 * 16 + 8);
    rC[0] = *(const u32x4*)(src + 640 + grp * 64 + q4 * 16); rC[1] = *(const u32x4*)(src + 640 + grp * 64 + q4 * 16 + 8);
    rdt = p.DTA[row * 16 + dir * 4 + hh];
  };
  f32x16 Sacc[2];
#pragma unroll
  for (int i = 0; i < 16; ++i) { Sacc[0][i] = 0.f; Sacc[1][i] = 0.f; }
  load_regs(0);
  constexpr int NCH = TPB / 64;
#pragma unroll 1
  for (int c = 0; c < NCH; ++c) {
    const int tl = ttlo_of(c);
    if (w == 0) {
      const int tt = dir ? tl + 63 - lane : tl + lane;
      float a = p.DTA[(rowbase + tt) * 16 + 8 + dir * 4 + hh];
#pragma unroll
      for (int o = 1; o < 64; o <<= 1) { const float t = __shfl_up(a, o); if (lane >= o) a += t; }
      csm[lane] = a;
    }
    __syncthreads();
    {
      const float wj = __expf(csm[63] - csm[jst]);
      *(u32x4*)(Cq + jst * 144 + q4 * 32) = rC[0]; *(u32x4*)(Cq + jst * 144 + q4 * 32 + 16) = rC[1];
      *(u32x4*)(Bk + jst * 144 + q4 * 32) = rB[0]; *(u32x4*)(Bk + jst * 144 + q4 * 32 + 16) = rB[1];
      float xb[16], bb[16];
      unpack8(rx[0], xb); unpack8(rx[1], xb + 8);
      unpack8(rB[0], bb); unpack8(rB[1], bb + 8);
#pragma unroll
      for (int e = 0; e < 16; ++e) {
        const int ch = q4 * 16 + e;
        const float xd = xb[e] * rdt;
        *(u16*)(Btr + ch * 144 + jst * 2) = f2bf(bb[e]);
        *(u16*)(XT + ch * 136 + jst * 2) = f2bf(xd);
        *(u16*)(XTs + ch * 144 + jst * 2) = f2bf(xd * wj);
      }
    }
    if (c + 1 < NCH) load_regs(c + 1);
    __syncthreads();
    {
      const int jg = 32 * jb + lr;
      const float csj = csm[jg];
      const float decay_all = __expf(csm[63]);
      bf16x8 cfr[4];
#pragma unroll
      for (int ks = 0; ks < 4; ++ks) cfr[ks] = *(const bf16x8*)(Cq + jg * 144 + ks * 32 + lh * 16);
      f32x16 st[2];
#pragma unroll
      for (int i = 0; i < 16; ++i) { st[0][i] = 0.f; st[1][i] = 0.f; }
#pragma unroll
      for (int sb = 0; sb < 2; ++sb)
#pragma unroll
        for (int ks = 0; ks < 4; ++ks) {
          const bf16x8 bfr = *(const bf16x8*)(Bk + (32 * sb + lr) * 144 + ks * 32 + lh * 16);
          st[sb] = MFMA32(bfr, cfr[ks], st[sb]);
        }
      f32x16 acc2;
#pragma unroll
      for (int i = 0; i < 16; ++i) acc2[i] = 0.f;
#pragma unroll
      for (int nb = 0; nb < 2; ++nb)
#pragma unroll
        for (int s2 = 0; s2 < 2; ++s2) {
          u32x4 pk;
          pk.x = pack2(Sacc[nb][8 * s2 + 0], Sacc[nb][8 * s2 + 1]);
          pk.y = pack2(Sacc[nb][8 * s2 + 2], Sacc[nb][8 * s2 + 3]);
          pk.z = pack2(Sacc[nb][8 * s2 + 4], Sacc[nb][8 * s2 + 5]);
          pk.w = pack2(Sacc[nb][8 * s2 + 6], Sacc[nb][8 * s2 + 7]);
          const char* cp = Cq + jg * 144 + (32 * nb + 16 * s2 + 4 * lh) * 2;
          const uint2 c0 = *(const uint2*)(cp);
          const uint2 c1 = *(const uint2*)(cp + 16);
          const bf16x8 cperm = __builtin_bit_cast(bf16x8, ((u32x4){c0.x, c0.y, c1.x, c1.y}));
          acc2 = MFMA32(__builtin_bit_cast(bf16x8, pk), cperm, acc2);
        }
      f32x16 acc;
#pragma unroll
      for (int i = 0; i < 16; ++i) acc[i] = 0.f;
#pragma unroll
      for (int sb = 0; sb < 2; ++sb) {
#pragma unroll
        for (int g = 0; g < 4; ++g) {
          const float4 c4 = *(const float4*)(csm + 32 * sb + 8 * g + 4 * lh);
          const float cv[4] = {c4.x, c4.y, c4.z, c4.w};
#pragma unroll
          for (int e = 0; e < 4; ++e) {
            const int sg = 32 * sb + 8 * g + 4 * lh + e;
            const float f = __expf(csj - cv[e]);
            st[sb][4 * g + e] = (sg <= jg) ? st[sb][4 * g + e] * f : 0.f;
          }
        }
#pragma unroll
        for (int s2 = 0; s2 < 2; ++s2) {
          u32x4 pk;
          pk.x = pack2(st[sb][8 * s2 + 0], st[sb][8 * s2 + 1]);
          pk.y = pack2(st[sb][8 * s2 + 2], st[sb][8 * s2 + 3]);
          pk.z = pack2(st[sb][8 * s2 + 4], st[sb][8 * s2 + 5]);
          pk.w = pack2(st[sb][8 * s2 + 6], st[sb][8 * s2 + 7]);
          const char* xp = XT + (32 * pb + lr) * 136 + (32 * sb + 16 * s2 + 4 * lh) * 2;
          const uint2 x0 = *(const uint2*)(xp);
          const uint2 x1 = *(const uint2*)(xp + 16);
          const bf16x8 xfr = __builtin_bit_cast(bf16x8, ((u32x4){x0.x, x0.y, x1.x, x1.y}));
          acc = MFMA32(xfr, __builtin_bit_cast(bf16x8, pk), acc);
        }
      }
      {
        const float ej = __expf(csj);
        const int tt = dir ? tl + 63 - jg : tl + jg;
        u16* op = p.RY + (rowbase + tt) * 512 + dir * 256 + hh * 64 + 32 * pb + 4 * lh;
#pragma unroll
        for (int g = 0; g < 4; ++g) {
          uint2 o;
          o.x = pack2(acc[4 * g] + ej * acc2[4 * g], acc[4 * g + 1] + ej * acc2[4 * g + 1]);
          o.y = pack2(acc[4 * g + 2] + ej * acc2[4 * g + 2], acc[4 * g + 3] + ej * acc2[4 * g + 3]);
          *(uint2*)(op + 8 * g) = o;
        }
      }
#pragma unroll
      for (int nb = 0; nb < 2; ++nb) {
#pragma unroll
        for (int i = 0; i < 16; ++i) Sacc[nb][i] *= decay_all;
#pragma unroll
        for (int ks = 0; ks < 4; ++ks) {
          const bf16x8 afr = *(const bf16x8*)(Btr + (32 * nb + lr) * 144 + ks * 32 + lh * 16);
          const bf16x8 bfr = *(const bf16x8*)(XTs + (32 * pb + lr) * 144 + ks * 32 + lh * 16);
          Sacc[nb] = MFMA32(afr, bfr, Sacc[nb]);
        }
      }
    }
    __syncthreads();
  }
}

DI void readout_tile(const Params& p, int l, int t) {
  const int tid_ = opq(threadIdx.x & 255); const int lane = tid_ & 63, wid = tid_ >> 6;
  const int c4 = lane * 4;
  float hg[4], sg[4], dsk;
#pragma unroll
  for (int e = 0; e < 4; ++e) {
    hg[e] = p.hg_norm_g[l * 256 + c4 + e];
    sg[e] = p.ssm_norm_g[l * 256 + c4 + e];
  }
  dsk = p.ssm_d[l * 4 + (lane >> 4)];
#pragma unroll 2
  for (int rr = 0; rr < 8; ++rr) {
    const int row = t * 32 + wid * 8 + rr;
    const int tt = row % TPB;
    const u16* Pr = p.P + (size_t)row * INP;
    {
      const uint2 of = *(const uint2*)(p.RO + (size_t)row * 512 + c4);
      const uint2 obk = *(const uint2*)(p.RO + (size_t)row * 512 + 256 + c4);
      const uint2 og = *(const uint2*)(Pr + O1 + 1024 + c4);
      float o[4] = {lo2f(of.x) + lo2f(obk.x), hi2f(of.x) + hi2f(obk.x), lo2f(of.y) + lo2f(obk.y), hi2f(of.y) + hi2f(obk.y)};
      float ss = o[0] * o[0] + o[1] * o[1] + o[2] * o[2] + o[3] * o[3];
      ss = row_sum16(ss);
      const float r = rsqrtf(ss * (1.f / 64.f) + 1e-6f);
      const float g[4] = {lo2f(og.x), hi2f(og.x), lo2f(og.y), hi2f(og.y)};
      uint2 ov;
      ov.x = pack2(o[0] * r * hg[0] * siluf(g[0]), o[1] * r * hg[1] * siluf(g[1]));
      ov.y = pack2(o[2] * r * hg[2] * siluf(g[2]), o[3] * r * hg[3] * siluf(g[3]));
      *(uint2*)(p.ACT + (size_t)row * DM + 512 + c4) = ov;
    }
    {
      const uint2 yf = *(const uint2*)(p.RY + (size_t)row * 512 + c4);
      const uint2 yb = *(const uint2*)(p.RY + (size_t)row * 512 + 256 + c4);
      const uint2 zz = *(const uint2*)(Pr + O2 + c4);
      const uint2 xc = *(const uint2*)(p.ACT + (size_t)row * DM + 768 + c4);
      const float a[4] = {lo2f(xc.x), hi2f(xc.x), lo2f(xc.y), hi2f(xc.y)};
      const float z[4] = {lo2f(zz.x), hi2f(zz.x), lo2f(zz.y), hi2f(zz.y)};
      const float yy[4] = {lo2f(yf.x) + lo2f(yb.x), hi2f(yf.x) + hi2f(yb.x), lo2f(yf.y) + lo2f(yb.y), hi2f(yf.y) + hi2f(yb.y)};
      float v[4], ss = 0.f;
#pragma unroll
      for (int e = 0; e < 4; ++e) { v[e] = (yy[e] + dsk * a[e]) * siluf(z[e]); ss = fmaf(v[e], v[e], ss); }
      ss = row_sum16(ss);
      {
        const float lo = rdlane(ss, 0) + rdlane(ss, 16), hi = rdlane(ss, 32) + rdlane(ss, 48);
        ss = (lane < 32) ? lo : hi;
      }
      const float r = rsqrtf(ss * (1.f / 128.f) + 1e-6f);
      uint2 ov;
      ov.x = pack2(v[0] * r * sg[0], v[1] * r * sg[1]);
      ov.y = pack2(v[2] * r * sg[2], v[3] * r * sg[3]);
      *(uint2*)(p.ACT + (size_t)row * DM + 768 + c4) = ov;
    }
  }
}

DI void attn_tile(const Params& p, int bh, int qt, char* smem) {
  const int b = bh >> 3, hh = bh & 7;
  const int nkt = (qt < 2) ? 4 : 68;
  const int tid = opq(threadIdx.x), lane = tid & 63, w = tid >> 6, lr = lane & 31, lh = lane >> 5;
  const size_t rowbase = (size_t)b * TPB;
  const size_t qrow = rowbase + qt * 128 + w * 32 + lr;
  bf16x8 qf[6];
  {
    const u16* qp = p.Q + qrow * 768 + hh * 96 + lh * 8;
#pragma unroll
    for (int s = 0; s < 6; ++s) qf[s] = *(const bf16x8*)(qp + 16 * s);
  }
  u32x4 rk[3], rv[2];
  auto load_tiles = [&](int kt) {
#pragma unroll
    for (int i = 0; i < 3; ++i) {
      const int idx = tid + 256 * i, key = idx / 12, ch = idx % 12;
      const size_t kr = rowbase + kt * 64 + key;
      rk[i] = (ch < 8) ? *(const u32x4*)(p.Kn + kr * 512 + hh * 64 + ch * 8) : *(const u32x4*)(p.KR + kr * 32 + (ch - 8) * 8);
    }
#pragma unroll
    for (int i = 0; i < 2; ++i) {
      const int idx = tid + 256 * i, vd = idx >> 3, ch = idx & 7;
      rv[i] = *(const u32x4*)(p.Vt + ((size_t)bh * 64 + vd) * TPB + kt * 64 + ch * 8);
    }
  };
  auto store_tiles = [&](int st) {
    char* Ks = smem + st * 22016;
    char* Vs = Ks + 13312;
#pragma unroll
    for (int i = 0; i < 3; ++i) {
      const int idx = tid + 256 * i, key = idx / 12, ch = idx % 12;
      *(u32x4*)(Ks + key * 208 + ch * 16) = rk[i];
    }
#pragma unroll
    for (int i = 0; i < 2; ++i) {
      const int idx = tid + 256 * i, vd = idx >> 3, ch = idx & 7;
      uint2* d = (uint2*)(Vs + vd * 136 + ch * 16);
      d[0] = make_uint2(rv[i].x, rv[i].y);
      d[1] = make_uint2(rv[i].z, rv[i].w);
    }
  };
  f32x16 O[2];
#pragma unroll
  for (int i = 0; i < 16; ++i) { O[0][i] = 0.f; O[1][i] = 0.f; }
  float m = -1e30f, lsum = 0.f;
  load_tiles(0);
  store_tiles(0);
  __syncthreads();
#pragma unroll 1
  for (int kt = 0; kt < nkt; ++kt) {
    const bool more = kt + 1 < nkt;
    if (more) load_tiles(kt + 1);
    const char* Ks = smem + (kt & 1) * 22016;
    const char* Vs = Ks + 13312;
    f32x16 st[2];
#pragma unroll
    for (int i = 0; i < 16; ++i) { st[0][i] = 0.f; st[1][i] = 0.f; }
    {
      bf16x8 kf[2][6];
#pragma unroll
      for (int kb = 0; kb < 2; ++kb)
#pragma unroll
        for (int s = 0; s < 6; ++s) kf[kb][s] = *(const bf16x8*)(Ks + (kb * 32 + lr) * 208 + s * 32 + lh * 16);
      __builtin_amdgcn_s_setprio(1);
#pragma unroll
      for (int s = 0; s < 6; ++s) {
        st[0] = MFMA32(kf[0][s], qf[s], st[0]);
        st[1] = MFMA32(kf[1][s], qf[s], st[1]);
      }
      __builtin_amdgcn_s_setprio(0);
    }
    u32x4 vf[2][2][2];
#pragma unroll
    for (int kb = 0; kb < 2; ++kb)
#pragma unroll
      for (int s2 = 0; s2 < 2; ++s2)
#pragma unroll
        for (int vb = 0; vb < 2; ++vb) {
          const char* vp = Vs + (vb * 32 + lr) * 136 + (kb * 32 + 16 * s2 + 4 * lh) * 2;
          const uint2 v0 = *(const uint2*)(vp);
          const uint2 v1 = *(const uint2*)(vp + 16);
          vf[kb][s2][vb] = (u32x4){v0.x, v0.y, v1.x, v1.y};
        }
    float mx = st[0][0];
#pragma unroll
    for (int i = 1; i < 16; ++i) mx = fmaxf(mx, st[0][i]);
#pragma unroll
    for (int i = 0; i < 16; ++i) mx = fmaxf(mx, st[1][i]);
    mx = fmaxf(mx, __shfl_xor(mx, 32));
    const float mn = fmaxf(m, mx);
    const float alpha = __builtin_amdgcn_exp2f(m - mn);
    m = mn;
    float ps = 0.f;
#pragma unroll
    for (int kb = 0; kb < 2; ++kb)
#pragma unroll
      for (int i = 0; i < 16; ++i) { st[kb][i] = __builtin_amdgcn_exp2f(st[kb][i] - mn); ps += st[kb][i]; }
    lsum = lsum * alpha + ps;
#pragma unroll
    for (int i = 0; i < 16; ++i) { O[0][i] *= alpha; O[1][i] *= alpha; }
#pragma unroll
    for (int kb = 0; kb < 2; ++kb)
#pragma unroll
      for (int s2 = 0; s2 < 2; ++s2) {
        u32x4 pk;
        pk.x = pack2(st[kb][8 * s2 + 0], st[kb][8 * s2 + 1]);
        pk.y = pack2(st[kb][8 * s2 + 2], st[kb][8 * s2 + 3]);
        pk.z = pack2(st[kb][8 * s2 + 4], st[kb][8 * s2 + 5]);
        pk.w = pack2(st[kb][8 * s2 + 6], st[kb][8 * s2 + 7]);
        const bf16x8 bfrag = __builtin_bit_cast(bf16x8, pk);
        O[0] = MFMA32(__builtin_bit_cast(bf16x8, vf[kb][s2][0]), bfrag, O[0]);
        O[1] = MFMA32(__builtin_bit_cast(bf16x8, vf[kb][s2][1]), bfrag, O[1]);
      }
    if (more) store_tiles((kt + 1) & 1);
    __syncthreads();
  }
  const float ltot = lsum + __shfl_xor(lsum, 32);
  const float inv = 1.f / ltot;
  u16* op = p.ACT + qrow * DM + hh * 64;
#pragma unroll
  for (int vb = 0; vb < 2; ++vb)
#pragma unroll
    for (int g = 0; g < 4; ++g) {
      uint2 o;
      o.x = pack2(O[vb][4 * g] * inv, O[vb][4 * g + 1] * inv);
      o.y = pack2(O[vb][4 * g + 2] * inv, O[vb][4 * g + 3] * inv);
      *(uint2*)(op + vb * 32 + 8 * g + 4 * lh) = o;
    }
}

DI void attn_tile8(const Params& p, int bh, int qt, char* smem) {
  const int b = bh >> 3, hh = bh & 7;
  const int nkt = (qt < 1) ? 2 : 34;
  const int tid = opq(threadIdx.x), lane = tid & 63, w = tid >> 6, lr = lane & 31, lh = lane >> 5;
  const size_t rowbase = (size_t)b * TPB;
  const size_t qrow = rowbase + qt * 256 + w * 32 + lr;
  constexpr int STAGE = 43520, VOFF = 26624, VROW = 264;
  bf16x8 qf[6];
  {
    const u16* qp = p.Q + qrow * 768 + hh * 96 + lh * 8;
#pragma unroll
    for (int s = 0; s < 6; ++s) qf[s] = *(const bf16x8*)(qp + 16 * s);
  }
  u32x4 rk[3], rv[2];
  auto load_tiles = [&](int kt) {
#pragma unroll
    for (int i = 0; i < 3; ++i) {
      const int idx = tid + 512 * i, key = idx / 12, ch = idx % 12;
      const size_t kr = rowbase + kt * 128 + key;
      rk[i] = (ch < 8) ? *(const u32x4*)(p.Kn + kr * 512 + hh * 64 + ch * 8) : *(const u32x4*)(p.KR + kr * 32 + (ch - 8) * 8);
    }
#pragma unroll
    for (int i = 0; i < 2; ++i) {
      const int idx = tid + 512 * i, vd = idx >> 4, ch = idx & 15;
      rv[i] = *(const u32x4*)(p.Vt + ((size_t)bh * 64 + vd) * TPB + kt * 128 + ch * 8);
    }
  };
  auto store_tiles = [&](int st) {
    char* Ks = smem + st * STAGE;
    char* Vs = Ks + VOFF;
#pragma unroll
    for (int i = 0; i < 3; ++i) {
      const int idx = tid + 512 * i, key = idx / 12, ch = idx % 12;
      *(u32x4*)(Ks + key * 208 + ch * 16) = rk[i];
    }
#pragma unroll
    for (int i = 0; i < 2; ++i) {
      const int idx = tid + 512 * i, vd = idx >> 4, ch = idx & 15;
      uint2* d = (uint2*)(Vs + vd * VROW + ch * 16);
      d[0] = make_uint2(rv[i].x, rv[i].y);
      d[1] = make_uint2(rv[i].z, rv[i].w);
    }
  };
  f32x16 O[2];
#pragma unroll
  for (int i = 0; i < 16; ++i) { O[0][i] = 0.f; O[1][i] = 0.f; }
  float m = -1e30f, lsum = 0.f;
  load_tiles(0);
  store_tiles(0);
  __syncthreads();
#pragma unroll 1
  for (int kt = 0; kt < nkt; ++kt) {
    const bool more = kt + 1 < nkt;
    if (more) load_tiles(kt + 1);
    const char* Ks = smem + (kt & 1) * STAGE;
    const char* Vs = Ks + VOFF;
    f32x16 st[4];
#pragma unroll
    for (int kb = 0; kb < 4; ++kb)
#pragma unroll
      for (int i = 0; i < 16; ++i) st[kb][i] = 0.f;
    {
      bf16x8 kf[2][4];
#pragma unroll
      for (int kb = 0; kb < 4; ++kb) kf[0][kb] = *(const bf16x8*)(Ks + (kb * 32 + lr) * 208 + lh * 16);
#pragma unroll
      for (int s = 0; s < 6; ++s) {
        if (s < 5) {
#pragma unroll
          for (int kb = 0; kb < 4; ++kb) kf[(s + 1) & 1][kb] = *(const bf16x8*)(Ks + (kb * 32 + lr) * 208 + (s + 1) * 32 + lh * 16);
        }
        __builtin_amdgcn_sched_barrier(0);
        __builtin_amdgcn_s_setprio(1);
#pragma unroll
        for (int kb = 0; kb < 4; ++kb) st[kb] = MFMA32(kf[s & 1][kb], qf[s], st[kb]);
        __builtin_amdgcn_s_setprio(0);
        __builtin_amdgcn_sched_barrier(0);
      }
    }
    float mx = st[0][0];
#pragma unroll
    for (int kb = 0; kb < 4; ++kb)
#pragma unroll
      for (int i = 0; i < 16; ++i) mx = fmaxf(mx, st[kb][i]);
    mx = fmaxf(mx, __shfl_xor(mx, 32));
    const float mn = fmaxf(m, mx);
    const float alpha = __builtin_amdgcn_exp2f(m - mn);
    m = mn;
    float ps = 0.f;
#pragma unroll
    for (int kb = 0; kb < 4; ++kb)
#pragma unroll
      for (int i = 0; i < 16; ++i) { st[kb][i] = __builtin_amdgcn_exp2f(st[kb][i] - mn); ps += st[kb][i]; }
    lsum = lsum * alpha + ps;
#pragma unroll
    for (int i = 0; i < 16; ++i) { O[0][i] *= alpha; O[1][i] *= alpha; }
    {
      u32x4 vfr[2][2];
#pragma unroll
      for (int vb = 0; vb < 2; ++vb) {
        const char* vp = Vs + (vb * 32 + lr) * VROW + (4 * lh) * 2;
        const uint2 v0 = *(const uint2*)(vp);
        const uint2 v1 = *(const uint2*)(vp + 16);
        vfr[0][vb] = (u32x4){v0.x, v0.y, v1.x, v1.y};
      }
#pragma unroll
      for (int step = 0; step < 8; ++step) {
        const int kb = step >> 1, s2 = step & 1;
        if (step < 7) {
          const int kb2 = (step + 1) >> 1, s22 = (step + 1) & 1;
#pragma unroll
          for (int vb = 0; vb < 2; ++vb) {
            const char* vp = Vs + (vb * 32 + lr) * VROW + (kb2 * 32 + 16 * s22 + 4 * lh) * 2;
            const uint2 v0 = *(const uint2*)(vp);
            const uint2 v1 = *(const uint2*)(vp + 16);
            vfr[(step + 1) & 1][vb] = (u32x4){v0.x, v0.y, v1.x, v1.y};
          }
        }
        u32x4 pk;
        pk.x = pack2(st[kb][8 * s2 + 0], st[kb][8 * s2 + 1]);
        pk.y = pack2(st[kb][8 * s2 + 2], st[kb][8 * s2 + 3]);
        pk.z = pack2(st[kb][8 * s2 + 4], st[kb][8 * s2 + 5]);
        pk.w = pack2(st[kb][8 * s2 + 6], st[kb][8 * s2 + 7]);
        const bf16x8 bfrag = __builtin_bit_cast(bf16x8, pk);
        __builtin_amdgcn_sched_barrier(0);
        O[0] = MFMA32(__builtin_bit_cast(bf16x8, vfr[step & 1][0]), bfrag, O[0]);
        O[1] = MFMA32(__builtin_bit_cast(bf16x8, vfr[step & 1][1]), bfrag, O[1]);
        __builtin_amdgcn_sched_barrier(0);
      }
    }
    if (more) store_tiles((kt + 1) & 1);
    __syncthreads();
  }
  const float ltot = lsum + __shfl_xor(lsum, 32);
  const float inv = 1.f / ltot;
  u16* op = p.ACT + qrow * DM + hh * 64;
#pragma unroll
  for (int vb = 0; vb < 2; ++vb)
#pragma unroll
    for (int g = 0; g < 4; ++g) {
      uint2 o;
      o.x = pack2(O[vb][4 * g] * inv, O[vb][4 * g + 1] * inv);
      o.y = pack2(O[vb][4 * g + 2] * inv, O[vb][4 * g + 3] * inv);
      *(uint2*)(op + vb * 32 + 8 * g + 4 * lh) = o;
    }
}

DI void final_tile(const Params& p, int t) {
  const int tid_ = opq(threadIdx.x & 255); const int lane = tid_ & 63, wid = tid_ >> 6;
  float4 G[4];
#pragma unroll
  for (int j = 0; j < 4; ++j) G[j] = *(const float4*)(p.final_g + lane * 4 + 256 * j);
  float* h0 = p.Hl + ((size_t)t * 32 + wid * 8) * DM;
#pragma unroll 1
  for (int rr = 0; rr < 8; rr += 2) {
    float4 v[2][4];
    float ss[2] = {0.f, 0.f};
#pragma unroll
    for (int u = 0; u < 2; ++u)
#pragma unroll
      for (int j = 0; j < 4; ++j) v[u][j] = *(const float4*)(h0 + (size_t)(rr + u) * DM + lane * 4 + 256 * j);
#pragma unroll
    for (int u = 0; u < 2; ++u)
#pragma unroll
      for (int j = 0; j < 4; ++j)
        ss[u] += v[u][j].x * v[u][j].x + v[u][j].y * v[u][j].y + v[u][j].z * v[u][j].z + v[u][j].w * v[u][j].w;
    ss[0] = wave_sum(ss[0]); ss[1] = wave_sum(ss[1]);
#pragma unroll
    for (int u = 0; u < 2; ++u) {
      const float r = rsqrtf(ss[u] * (1.f / DM) + 1e-6f);
#pragma unroll
      for (int j = 0; j < 4; ++j)
        *(float4*)(h0 + (size_t)(rr + u) * DM + lane * 4 + 256 * j) =
            make_float4(v[u][j].x * r * G[j].x, v[u][j].y * r * G[j].y, v[u][j].z * r * G[j].z, v[u][j].w * r * G[j].w);
    }
  }
}

#define XB_TMO      128
#define XB_XCNT(j)  (256  + 64 * (j))
#define XB_XSUB(j)  (1280 + 64 * (j))
#define XB_XGEN(j)  (2304 + 64 * (j))
#define XB_TOP      3328
#define XB_TOPGEN   3392
#define XCD_BAR_WORDS 3456
#define XB_SPIN_CAP (1u << 22)
#define LAS __attribute__((address_space(3)))
DI unsigned xb_ld(unsigned* p) { return __hip_atomic_load(p, __ATOMIC_RELAXED, __HIP_MEMORY_SCOPE_AGENT); }
DI unsigned xb_add(unsigned* p, unsigned v) { return __hip_atomic_fetch_add(p, v, __ATOMIC_RELAXED, __HIP_MEMORY_SCOPE_AGENT); }
DI unsigned xb_xcc_id() { return (unsigned)__builtin_amdgcn_s_getreg((3 << 11) | 20) & 0xFu; }
#define XB_SPIN(cond, bar) do { unsigned _sp = 0; while (cond) { __builtin_amdgcn_s_sleep(1); \
    if ((++_sp & 255u) == 0u) { if (xb_ld(&(bar)[XB_TMO])) break; if (_sp > XB_SPIN_CAP) { atomicAdd(&(bar)[XB_TMO], 1u); break; } } } } while (0)
struct XcdBarrier { unsigned* bar; unsigned x; volatile LAS unsigned* st; };
DI XcdBarrier xcd_barrier_post(unsigned* bar, volatile LAS unsigned* st) {
  XcdBarrier b; b.bar = bar; b.x = xb_xcc_id(); b.st = st;
  if (threadIdx.x == 0) (void)xb_add(&bar[XB_XCNT(b.x)], 1u);
  return b;
}
DI void xcd_barrier_complete(unsigned* bar, unsigned x, unsigned& nloc, unsigned& nx) {
  const unsigned G = gridDim.x * gridDim.y * gridDim.z;
  unsigned sum, cnt, mine, sp = 0u;
  for (;;) {
    sum = 0u; cnt = 0u; mine = 0u;
#pragma unroll
    for (unsigned j = 0; j < 16; ++j) { const unsigned c = xb_ld(&bar[XB_XCNT(j)]); sum += c; cnt += (c > 0u) ? 1u : 0u; mine = (j == x) ? c : mine; }
    if (sum == G) break;
    __builtin_amdgcn_s_sleep(1);
    if ((++sp & 255u) == 0u) { if (xb_ld(&bar[XB_TMO])) break; if (sp > XB_SPIN_CAP) { atomicAdd(&bar[XB_TMO], 1u); break; } }
  }
  nloc = mine > 0u ? mine : 1u; nx = cnt > 0u ? cnt : 1u;
}
DI void xcd_barrier(const XcdBarrier& b) {
  asm volatile("s_waitcnt vmcnt(0)" ::: "memory");
  __syncthreads();
  if (threadIdx.x == 0) {
    unsigned* bar = b.bar;
    __builtin_amdgcn_s_waitcnt(0);
    unsigned nloc = b.st[0], nx = b.st[1];
    if (nloc == 0u) { xcd_barrier_complete(bar, b.x, nloc, nx); b.st[0] = nloc; b.st[1] = nx; }
    const unsigned old = xb_add(&bar[XB_XSUB(b.x)], 1u);
    const unsigned gen = old / nloc;
    if (old + 1u == (gen + 1u) * nloc) {
      __builtin_amdgcn_fence(__ATOMIC_RELEASE, "agent");
      asm volatile("s_waitcnt vmcnt(0)" ::: "memory");
      const unsigned og = xb_add(&bar[XB_TOP], 1u);
      const unsigned tg = og / nx;
      if (og + 1u == (tg + 1u) * nx) xb_add(&bar[XB_TOPGEN], 1u);
      else XB_SPIN(xb_ld(&bar[XB_TOPGEN]) == tg, bar);
      __builtin_amdgcn_fence(__ATOMIC_ACQUIRE, "agent");
      xb_add(&bar[XB_XGEN(b.x)], 1u);
      asm volatile("s_waitcnt vmcnt(0)" ::: "memory");
    } else {
      XB_SPIN(xb_ld(&bar[XB_XGEN(b.x)]) == gen, bar);
      __builtin_amdgcn_fence(__ATOMIC_ACQUIRE, "agent");
      asm volatile("s_waitcnt vmcnt(0)" ::: "memory");
    }
  }
  __syncthreads();
}

__global__ void __launch_bounds__(256, 2) mega(Params p) {
  extern __shared__ __attribute__((aligned(16))) char smem[];
  cg::grid_group grid = cg::this_grid();
  const int bid = blockIdx.x, nb = gridDim.x;
  volatile LAS unsigned* xb_st = (volatile LAS unsigned*)(smem + SMEM_BYTES - 32);
  if (threadIdx.x < 2) xb_st[threadIdx.x] = 0u;
  if (bid == 0) for (int i = threadIdx.x; i < XCD_BAR_WORDS; i += 256) p.bar[i] = 0u;
  __syncthreads();

  {
    const size_t nx4 = (size_t)NB * SEQ * DM / 4, nc4 = (size_t)NB * CTXL * DM / 4;
    const float4* xs4 = (const float4*)p.x; float4* xd4 = (float4*)p.Hl;
    for (size_t i = (size_t)bid * 256 + threadIdx.x; i < nx4; i += (size_t)nb * 256) xd4[i] = xs4[i];
    const float4* cs4 = (const float4*)p.ctx; float4* cd4 = (float4*)p.Hc;
    for (size_t i = (size_t)bid * 256 + threadIdx.x; i < nc4; i += (size_t)nb * 256) cd4[i] = cs4[i];
  }
  for (int t = bid; t < DEPTH * WT_LAYER; t += nb) wconv_tile(p, t, smem);
  for (int t = bid; t < DEPTH * 96; t += nb) ada_tile(p, t, smem);
  if (bid == nb - 1) tables(p);
  if (bid == 0 && threadIdx.x < 8) p.ctr[threadIdx.x] = 0;
  grid.sync();
  const XcdBarrier xb = xcd_barrier_post(p.bar, xb_st);

#pragma unroll 1
  for (int l = 0; l < DEPTH; ++l) {
    const u16* Wl = p.W + (size_t)l * W_LAYER;
    for (int t = bid; t < MROWS / 32; t += nb) norm_tile(p, l, 0, t);
    xcd_barrier(xb);
    gemm_phase<EPI_P, false, true>(p, l, p.ACT, DM, Wl + W_IN, 1024, INP / 128, 0, smem, bid, nb);
    xcd_barrier(xb);
    for (int t = bid; t < MROWS / 32; t += nb) ssmprep_tile(p, l, t);
    gemm_phase<EPI_Q, true, false>(p, l, p.P, INP, Wl + W_Q, 384, 6, 0, smem, bid, nb);
    gemm_phase<EPI_KV, true, true>(p, l, p.P + 384, INP, Wl + W_KV, 256, 8, 0, smem, bid, nb);
    for (int t = bid; t < MT; t += nb) krope_tile(p, t);
    xcd_barrier(xb);
    if (bid < 128) hgrn_chain(p, l, bid, smem);
    else if (bid < 256) ssm_chain(p, l, bid - 128, smem);
    {
      volatile int* s_tile = (volatile int*)(smem + SMEM_BYTES - 16);
      for (;;) {
        __syncthreads();
        if (threadIdx.x == 0) *s_tile = atomicAdd(p.ctr + l, 1);
        __syncthreads();
        const int t = *s_tile;
        if (t >= NB * 8 * 34) break;
        if (t < NB * 8 * 32) attn_tile(p, t >> 5, 2 + (t & 31), smem);
        else attn_tile(p, (t - NB * 8 * 32) >> 1, t & 1, smem);
      }
    }
    xcd_barrier(xb);
    for (int t = bid; t < MROWS / 32; t += nb) readout_tile(p, l, t);
    xcd_barrier(xb);
    gemm_phase<EPI_RES, false, true>(p, l, p.ACT, DM, Wl + W_OUT, 1024, 8, 2048, smem, bid, nb);
    xcd_barrier(xb);
    for (int t = bid; t < MROWS / 32; t += nb) norm_tile(p, l, 1, t);
    xcd_barrier(xb);
    gemm_phase<EPI_SWIGLU, false, true>(p, l, p.ACT, DM, Wl + W_FI, 1024, 44, 0, smem, bid, nb);
    xcd_barrier(xb);
    gemm_phase<EPI_RES, false, true>(p, l, p.P, FFH, Wl + W_FO, FFH, 8, 5120, smem, bid, nb);
    xcd_barrier(xb);
  }
  for (int t = bid; t < NB * SEQ / 32; t += nb) final_tile(p, t);
}

constexpr size_t SMEM8 = 155648;
constexpr size_t HALF_LDS = 76800;

__global__ void __launch_bounds__(512, 2) mega8(Params p) {
  extern __shared__ __attribute__((aligned(16))) char smem[];
  cg::grid_group grid = cg::this_grid();
  const int bid = blockIdx.x, nb = gridDim.x;
  const int half = __builtin_amdgcn_readfirstlane(threadIdx.x >> 8);
  const int vb = 2 * bid + half, nvb = 2 * nb;
  char* hsm = smem + (size_t)half * HALF_LDS;
  volatile LAS unsigned* xb_st = (volatile LAS unsigned*)(smem + SMEM8 - 32);
  if (threadIdx.x < 2) xb_st[threadIdx.x] = 0u;
  if (bid == 0) for (int i = threadIdx.x; i < XCD_BAR_WORDS; i += 512) p.bar[i] = 0u;
  __syncthreads();

  for (int t = vb; t < DEPTH * WT_LAYER; t += nvb) wconv_tile(p, t, hsm);
  for (int t = vb; t < DEPTH * 96; t += nvb) ada_tile(p, t, hsm);
  if (bid == nb - 1) tables(p);
  if (bid == 0 && threadIdx.x < 8) p.ctr[threadIdx.x] = 0;
  grid.sync();
  const XcdBarrier xb = xcd_barrier_post(p.bar, xb_st);

#pragma unroll 1
  for (int l = 0; l < DEPTH; ++l) {
    const u16* Wl = p.W + (size_t)l * W_LAYER;
    const bool lastl = (l == DEPTH - 1);
    for (int t = vb; t < MROWS / 32; t += nvb) norm_tile(p, l, 0, t, l == 0);
    xcd_barrier(xb);
    gemm_phase8<EPI_P, false>(p, l, p.ACT, DM, Wl + W_IN, 1024, INP / 256, 0, smem);
    xcd_barrier(xb);
    for (int t = vb; t < MROWS / 32; t += nvb) ssmprep_tile(p, l, t);
    gemm_phase<EPI_Q, true, false>(p, l, p.P, INP, Wl + W_Q, 384, 6, 0, hsm, vb, nvb);
    gemm_phase8<EPI_KV, true>(p, l, p.P + 384, INP, Wl + W_KV, 256, 4, 0, smem);
    for (int t = vb; t < MT; t += nvb) krope_tile(p, t);
    xcd_barrier(xb);
    if (vb < 128) hgrn_chain(p, l, vb, hsm);
    else if (vb < 256) ssm_chain(p, l, vb - 128, hsm);
    {
      volatile int* s_tile = (volatile int*)(smem + SMEM8 - 16);
      for (;;) {
        __syncthreads();
        if (threadIdx.x == 0) *s_tile = atomicAdd(p.ctr + l, 1);
        __syncthreads();
        const int t = *s_tile;
        if (t >= (lastl ? NB * 8 * 16 : NB * 8 * 17)) break;
        if (t < NB * 8 * 16) attn_tile8(p, t >> 4, 1 + (t & 15), smem);
        else attn_tile8(p, t - NB * 8 * 16, 0, smem);
      }
    }
    xcd_barrier(xb);
    for (int t = vb; t < MROWS / 32; t += nvb) readout_tile(p, l, t);
    xcd_barrier(xb);
    gemm_phase8<EPI_RES, false>(p, l, p.ACT, DM, Wl + W_OUT, 1024, 4, 2048, smem, lastl);
    xcd_barrier(xb);
    for (int t = vb; t < MROWS / 32; t += nvb) if (!lastl || (t % (TPB / 32)) >= CTXL / 32) norm_tile(p, l, 1, t);
    xcd_barrier(xb);
    gemm_phase8<EPI_SWIGLU, false>(p, l, p.ACT, DM, Wl + W_FI, 1024, 22, 0, smem, lastl);
    xcd_barrier(xb);
    gemm_phase8<EPI_RES, false>(p, l, p.P, FFH, Wl + W_FO, FFH, 4, 5120, smem, lastl);
    xcd_barrier(xb);
  }
  for (int t = vb; t < NB * SEQ / 32; t += nvb) final_tile(p, t);
}

extern "C" void kernel_launch(void* const* d_in, const int* in_sizes, int n_in, void* d_out, int out_size, void* d_ws,
                              size_t ws_size, hipStream_t stream) {
  static int grid_blocks = 0;
  if (!grid_blocks) {
    hipFuncSetAttribute((const void*)mega8, hipFuncAttributeMaxDynamicSharedMemorySize, (int)SMEM8);
    int dev = 0, cus = 0, per_cu = 0;
    hipGetDevice(&dev);
    hipDeviceGetAttribute(&cus, hipDeviceAttributeMultiprocessorCount, dev);
    hipOccupancyMaxActiveBlocksPerMultiprocessor(&per_cu, mega8, 512, SMEM8);
    if (per_cu > 1) per_cu = 1;
    grid_blocks = cus * per_cu;
  }
  Params p{};
  const float* const* in = (const float* const*)d_in;
  p.x = in[0]; p.c = in[1]; p.ctx = in[2]; p.c_ctx = in[3]; p.w_ada = in[4]; p.b_ada = in[5]; p.norm1_g = in[6];
  p.norm2_g = in[7]; p.w_in = in[8]; p.qa_g = in[9]; p.wqb = in[10]; p.kva_g = in[11]; p.wkvb = in[12];
  p.lb_logits = in[13]; p.hg_norm_g = in[14]; p.conv_w = in[15]; p.conv_b = in[16]; p.dt_bias = in[17];
  p.a_log = in[18]; p.ssm_d = in[19]; p.ssm_norm_g = in[20]; p.w_out = in[21]; p.w_ffn_in = in[22];
  p.w_ffn_out = in[23]; p.final_g = in[24];
  p.Hl = (float*)d_out;
  char* ws = (char*)d_ws;
  size_t off = 0;
  auto take = [&](size_t bytes) { char* r = ws + off; off += (bytes + 255) & ~(size_t)255; return r; };
  p.W = (u16*)take((size_t)DEPTH * W_LAYER * 2);
  p.mod = (float*)take((size_t)DEPTH * 17 * 6144 * 4);
  p.rope = (float*)take(64 * 8 * 2 * 4);
  p.lbt = (float*)take(DEPTH * 2 * 256 * 4);
  p.Hc = (float*)take((size_t)NB * CTXL * DM * 4);
  p.ACT = (u16*)take((size_t)MROWS * DM * 2);
  p.P = (u16*)take((size_t)MROWS * INP * 2);
  p.Q = (u16*)take((size_t)MROWS * 768 * 2);
  p.Kn = (u16*)take((size_t)MROWS * 512 * 2);
  p.Vt = (u16*)take((size_t)MROWS * 512 * 2);
  p.KR = (u16*)take((size_t)MROWS * 32 * 2);
  p.RO = (u16*)take((size_t)MROWS * 512 * 2);
  p.RY = (u16*)take((size_t)MROWS * 512 * 2);
  p.ctr = (int*)take(256);
  p.DTA = (float*)take((size_t)MROWS * 16 * 4);
  p.bar = (unsigned*)take(XCD_BAR_WORDS * 4);
  if (off > ws_size) fprintf(stderr, "workspace too small: need %zu have %zu\n", off, ws_size);
  void* args[] = {&p};
  hipError_t e = hipLaunchCooperativeKernel((const void*)mega8, dim3(grid_blocks), dim3(512), args, SMEM8, stream);
  if (e != hipSuccess) fprintf(stderr, "cooperative launch failed: %s (grid %d)\n", hipGetErrorString(e), grid_blocks);
}
```

```cpp
#include <hip/hip_runtime.h>
#include <hip/hip_cooperative_groups.h>
#include <cstdio>
namespace cg = cooperative_groups;

typedef unsigned short u16;
using bf16x8 = __attribute__((ext_vector_type(8))) short;
using f32x16 = __attribute__((ext_vector_type(16))) float;
typedef __attribute__((ext_vector_type(2))) float f32x2;
using u32x4 = __attribute__((ext_vector_type(4))) unsigned;
typedef __attribute__((ext_vector_type(2))) __bf16 bf16x2;
#define DI __device__ __forceinline__
#define MFMA32(a, b, c) __builtin_amdgcn_mfma_f32_32x32x16_bf16((a), (b), (c), 0, 0, 0)

constexpr int DM = 1024, NB = 16, SEQ = 4096, CTXL = 256, TPB = 4352, MROWS = NB * TPB, DEPTH = 4;
constexpr int INC = 2728, INP = 2816, FFH = 2816;
constexpr int MT = MROWS / 128;
constexpr int O1 = 672, O2 = 1952;
constexpr float QSCALE = 0.10206207261596577f * 1.4426950408889634f;
constexpr size_t SMEM_BYTES = 76800;

constexpr size_t W_IN = 0;
constexpr size_t W_Q = W_IN + (size_t)INP * 1024;
constexpr size_t W_KV = W_Q + (size_t)768 * 384;
constexpr size_t W_OUT = W_KV + (size_t)1024 * 256;
constexpr size_t W_FI = W_OUT + (size_t)1024 * 1024;
constexpr size_t W_FO = W_FI + (size_t)5632 * 1024;
constexpr size_t W_LAYER = W_FO + (size_t)1024 * FFH;
constexpr int WT_IN = 44 * 16, WT_Q = 12 * 6, WT_KV = 16 * 4, WT_OUT = 16 * 16, WT_FI = 88 * 16, WT_FO = 16 * 44;
constexpr int WT_LAYER = WT_IN + WT_Q + WT_KV + WT_OUT + WT_FI + WT_FO;

struct Params {
  const float *x, *c, *ctx, *c_ctx, *w_ada, *b_ada, *norm1_g, *norm2_g, *w_in, *qa_g, *wqb, *kva_g, *wkvb, *lb_logits,
      *hg_norm_g, *conv_w, *conv_b, *dt_bias, *a_log, *ssm_d, *ssm_norm_g, *w_out, *w_ffn_in, *w_ffn_out, *final_g;
  float* Hl;
  u16* W;
  float* mod;
  float* rope;
  float* lbt;
  float* Hc;
  u16* ACT;
  u16* P;
  u16* Q;
  u16* Kn;
  u16* Vt;
  u16* KR;
  u16* RO;
  u16* RY;
  int* ctr;
  float* DTA;
  unsigned* bar;
};

DI float bf2f(u16 v) { return __uint_as_float((unsigned)v << 16); }
DI unsigned pack2(float a, float b) {
  f32x2 v = {a, b};
  return __builtin_bit_cast(unsigned, __builtin_convertvector(v, bf16x2));
}
DI u16 f2bf(float a) { return (u16)(pack2(a, 0.f) & 0xffffu); }
DI float lo2f(unsigned u) { return __uint_as_float(u << 16); }
DI float hi2f(unsigned u) { return __uint_as_float(u & 0xffff0000u); }
DI float sigmoidf(float x) { return __builtin_amdgcn_rcpf(1.f + __expf(-x)); }
DI float siluf(float x) { return x * __builtin_amdgcn_rcpf(1.f + __expf(-x)); }
DI int opq(int x) { asm volatile("" : "+v"(x)); return x; }
template <int N>
DI float dpp_row_shr(float x) {
  return __builtin_bit_cast(float, __builtin_amdgcn_update_dpp(0, __builtin_bit_cast(int, x), 0x110 + N, 0xf, 0xf, true));
}
template <int CTRL>
DI float dpp_f(float x) {
  return __builtin_bit_cast(float, __builtin_amdgcn_update_dpp(0, __builtin_bit_cast(int, x), CTRL, 0xf, 0xf, true));
}
DI float row_sum16(float x) {
  x += dpp_f<0xB1>(x); x += dpp_f<0x4E>(x); x += dpp_f<0x141>(x); x += dpp_f<0x140>(x);
  return x;
}
DI float rdlane(float x, int l) { return __builtin_bit_cast(float, __builtin_amdgcn_readlane(__builtin_bit_cast(int, x), l)); }
DI float wave_sum(float x) {
  x = row_sum16(x);
  return (rdlane(x, 0) + rdlane(x, 16)) + (rdlane(x, 32) + rdlane(x, 48));
}
DI int crow(int i, int h) { return (i & 3) + 8 * (i >> 2) + 4 * h; }
DI void unpack8(const u32x4 r, float* f) {
  f[0] = lo2f(r.x); f[1] = hi2f(r.x); f[2] = lo2f(r.y); f[3] = hi2f(r.y);
  f[4] = lo2f(r.z); f[5] = hi2f(r.z); f[6] = lo2f(r.w); f[7] = hi2f(r.w);
}

DI void wconv_tile(const Params& p, int t, char* smem) {
  const int l = t / WT_LAYER;
  int r = t % WT_LAYER;
  const float* src; const float* gk = nullptr; u16* dst; int K, Nsrc, ntn, kind;
  u16* Wl = p.W + (size_t)l * W_LAYER;
  if (r < WT_IN) { src = p.w_in + (size_t)l * 1024 * INC; dst = Wl + W_IN; K = 1024; Nsrc = INC; ntn = 44; kind = 0; }
  else if ((r -= WT_IN) < WT_Q) { src = p.wqb + (size_t)l * 384 * 768; dst = Wl + W_Q; K = 384; Nsrc = 768; ntn = 12; kind = 1; gk = p.qa_g + l * 384; }
  else if ((r -= WT_Q) < WT_KV) { src = p.wkvb + (size_t)l * 256 * 1024; dst = Wl + W_KV; K = 256; Nsrc = 1024; ntn = 16; kind = 1; gk = p.kva_g + l * 256; }
  else if ((r -= WT_KV) < WT_OUT) { src = p.w_out + (size_t)l * 1024 * 1024; dst = Wl + W_OUT; K = 1024; Nsrc = 1024; ntn = 16; kind = 1; }
  else if ((r -= WT_OUT) < WT_FI) { src = p.w_ffn_in + (size_t)l * 1024 * 5632; dst = Wl + W_FI; K = 1024; Nsrc = 5632; ntn = 88; kind = 2; }
  else { r -= WT_FI; src = p.w_ffn_out + (size_t)l * FFH * 1024; dst = Wl + W_FO; K = FFH; Nsrc = 1024; ntn = 16; kind = 1; }
  const int n0 = (r % ntn) * 64, k0 = (r / ntn) * 64;
  float* tile = (float*)smem;
  const int tid = opq(threadIdx.x & 255);
  {
    const int nn4 = (tid & 15) * 4, kk = tid >> 4;
    const int n = n0 + nn4;
    int sn; bool valid = true;
    if (kind == 2) { const int j = n >> 6, w = n & 63; sn = (w < 32) ? (32 * j + w) : (FFH + 32 * j + (w - 32)); }
    else { sn = n; if (kind == 0) valid = n < INC; }
#pragma unroll
    for (int i = 0; i < 4; ++i) {
      const int k = k0 + kk + 16 * i;
      float4 v = make_float4(0.f, 0.f, 0.f, 0.f);
      if (valid) v = *(const float4*)(src + (size_t)k * Nsrc + sn);
      if (gk) { const float g = gk[k]; v.x *= g; v.y *= g; v.z *= g; v.w *= g; }
      float* tp = tile + (kk + 16 * i) * 65 + nn4;
      tp[0] = v.x; tp[1] = v.y; tp[2] = v.z; tp[3] = v.w;
    }
  }
  __syncthreads();
  {
    const int nn = tid >> 2, kq = (tid & 3) * 16;
    unsigned o[8];
#pragma unroll
    for (int i = 0; i < 8; ++i) o[i] = pack2(tile[(kq + 2 * i) * 65 + nn], tile[(kq + 2 * i + 1) * 65 + nn]);
    uint4* d = (uint4*)(dst + (size_t)(n0 + nn) * K + k0 + kq);
    d[0] = make_uint4(o[0], o[1], o[2], o[3]);
    d[1] = make_uint4(o[4], o[5], o[6], o[7]);
  }
  __syncthreads();
}

DI void ada_tile(const Params& p, int t, char* smem) {
  const int l = t / 96, cb = (t % 96) * 64;
  float* sc = (float*)smem;
  const int tid = opq(threadIdx.x & 255);
  for (int i = tid; i < 17 * 1024; i += 256) {
    const int r = i >> 10, k = i & 1023;
    const float v = (r < 16) ? p.c[r * 1024 + k] : p.c_ctx[k];
    sc[i] = siluf(v);
  }
  __syncthreads();
  const int col = tid & 63, kq = tid >> 6;
  float acc[17];
#pragma unroll
  for (int r = 0; r < 17; ++r) acc[r] = 0.f;
  const float* wp = p.w_ada + ((size_t)l * 1024 + kq * 256) * 6144 + cb + col;
  for (int k = 0; k < 256; k += 4) {
    const float w0 = wp[(size_t)(k + 0) * 6144], w1 = wp[(size_t)(k + 1) * 6144], w2 = wp[(size_t)(k + 2) * 6144], w3 = wp[(size_t)(k + 3) * 6144];
#pragma unroll
    for (int r = 0; r < 17; ++r) {
      const float4 s = *(const float4*)(sc + r * 1024 + kq * 256 + k);
      acc[r] = fmaf(s.x, w0, fmaf(s.y, w1, fmaf(s.z, w2, fmaf(s.w, w3, acc[r]))));
    }
  }
  __syncthreads();
  float* red = (float*)smem;
#pragma unroll
  for (int r = 0; r < 17; ++r) red[(kq * 17 + r) * 64 + col] = acc[r];
  __syncthreads();
  for (int i = tid; i < 17 * 64; i += 256) {
    const int r = i >> 6, cc = i & 63;
    const float v = red[(0 * 17 + r) * 64 + cc] + red[(1 * 17 + r) * 64 + cc] + red[(2 * 17 + r) * 64 + cc] + red[(3 * 17 + r) * 64 + cc];
    p.mod[((size_t)l * 17 + r) * 6144 + cb + cc] = v + p.b_ada[l * 6144 + cb + cc];
  }
  __syncthreads();
}

DI void tables(const Params& p) {
  const int tid = opq(threadIdx.x);
  for (int i = tid; i < 512; i += 256) {
    const int pos = i >> 3, f = i & 7;
    const float inv = powf(10000.f, -(float)f / 8.f);
    const float ang = (float)pos * inv;
    p.rope[i * 2] = cosf(ang);
    p.rope[i * 2 + 1] = sinf(ang);
  }
  for (int i = tid; i < 512; i += 256) {
    float lg[4], mx = -1e30f;
#pragma unroll
    for (int l = 0; l < 4; ++l) { lg[l] = p.lb_logits[l * 512 + i]; mx = fmaxf(mx, lg[l]); }
    float s = 0.f;
#pragma unroll
    for (int l = 0; l < 4; ++l) { lg[l] = expf(lg[l] - mx); s += lg[l]; }
    float cum = 0.f;
#pragma unroll
    for (int l = 0; l < 4; ++l) { if (l > 0) cum += lg[l] / s; p.lbt[l * 512 + i] = cum; }
  }
}

DI const float* hrow_in(const Params& p, int row) {
  const int b = row / TPB, tt = row % TPB;
  if (tt < CTXL) return p.Hc + ((size_t)b * CTXL + tt) * DM;
  return p.Hl + ((size_t)b * SEQ + (tt - CTXL)) * DM;
}
DI void norm_tile(const Params& p, int l, int which, int t, bool first = false) {
  const int tid_ = opq(threadIdx.x & 255); const int lane = tid_ & 63, wid = tid_ >> 6;
  const float* ng = (which ? p.norm2_g : p.norm1_g) + l * DM;
  const int row0 = t * 32 + wid * 8;
  const int b = row0 / TPB, tt0 = row0 % TPB;
  const float* md = p.mod + ((size_t)l * 17 + (tt0 < CTXL ? 16 : b)) * 6144 + which * 3072;
  float4 G[4], SH[4];
#pragma unroll
  for (int j = 0; j < 4; ++j) {
    const int col = lane * 4 + 256 * j;
    const float4 g = *(const float4*)(ng + col);
    const float4 sc = *(const float4*)(md + 1024 + col);
    SH[j] = *(const float4*)(md + col);
    G[j] = make_float4(g.x * (1.f + sc.x), g.y * (1.f + sc.y), g.z * (1.f + sc.z), g.w * (1.f + sc.w));
  }
  float* hres = (float*)hrow_in(p, row0);
  const float* h0 = hres;
  if (first) h0 = (tt0 < CTXL) ? p.ctx + ((size_t)b * CTXL + tt0) * DM : p.x + ((size_t)b * SEQ + (tt0 - CTXL)) * DM;
  float4 v[2][4], vn[2][4];
#pragma unroll
  for (int u = 0; u < 2; ++u)
#pragma unroll
    for (int j = 0; j < 4; ++j) v[u][j] = *(const float4*)(h0 + (size_t)u * DM + lane * 4 + 256 * j);
#pragma unroll
  for (int rr = 0; rr < 8; rr += 2) {
    if (rr + 2 < 8) {
#pragma unroll
      for (int u = 0; u < 2; ++u)
#pragma unroll
        for (int j = 0; j < 4; ++j) vn[u][j] = *(const float4*)(h0 + (size_t)(rr + 2 + u) * DM + lane * 4 + 256 * j);
    }
    float ss[2] = {0.f, 0.f};
#pragma unroll
    for (int u = 0; u < 2; ++u)
#pragma unroll
      for (int j = 0; j < 4; ++j) {
        if (first) *(float4*)(hres + (size_t)(rr + u) * DM + lane * 4 + 256 * j) = v[u][j];
        ss[u] += v[u][j].x * v[u][j].x + v[u][j].y * v[u][j].y + v[u][j].z * v[u][j].z + v[u][j].w * v[u][j].w;
      }
    ss[0] = wave_sum(ss[0]); ss[1] = wave_sum(ss[1]);
#pragma unroll
    for (int u = 0; u < 2; ++u) {
      const float r = rsqrtf(ss[u] * (1.f / DM) + 1e-6f);
#pragma unroll
      for (int j = 0; j < 4; ++j) {
        uint2 o;
        o.x = pack2(v[u][j].x * r * G[j].x + SH[j].x, v[u][j].y * r * G[j].y + SH[j].y);
        o.y = pack2(v[u][j].z * r * G[j].z + SH[j].z, v[u][j].w * r * G[j].w + SH[j].w);
        *(uint2*)(p.ACT + (size_t)(row0 + rr + u) * DM + lane * 4 + 256 * j) = o;
      }
    }
#pragma unroll
    for (int u = 0; u < 2; ++u)
#pragma unroll
      for (int j = 0; j < 4; ++j) v[u][j] = vn[u][j];
  }
}

enum { EPI_P = 0, EPI_Q = 1, EPI_KV = 2, EPI_RES = 3, EPI_SWIGLU = 4 };

template <int EPI, int MB, int NWC>
DI void gemm_epi(const Params& p, int l, f32x16 (&acc)[MB][2], const float* rs, int mt, int nt, int gofs,
                 int wr, int wc, int lr, int lh) {
  lr = opq(lr); lh = opq(lh); wr = opq(wr);
  constexpr int TM = MB * 64, TN = NWC * 64, TPBT = TPB / TM, WRS = MB * 32;
  const int bidx = mt / TPBT, tt0 = (mt % TPBT) * TM;
  const bool isctx = tt0 < CTXL;
  if (EPI == EPI_P) {
#pragma unroll
    for (int nb = 0; nb < 2; ++nb) {
      const int cblk = nt * (NWC * 2) + wc * 2 + nb;
      const int col = cblk * 32 + lr;
      const int kind = (cblk >= 21 && cblk < 29) ? 1 : ((cblk >= 29 && cblk < 45) ? 2 : 0);
      float oml = 0.f;
      if (kind == 2) oml = 1.f - p.lbt[l * 512 + (col - 928)];
#pragma unroll
      for (int mb = 0; mb < MB; ++mb)
#pragma unroll
        for (int i = 0; i < 16; ++i) {
          const int row = mt * TM + wr * WRS + mb * 32 + crow(i, lh);
          float v = acc[mb][nb][i];
          if (kind == 1) v = siluf(v);
          else if (kind == 2) v = -oml * __builtin_amdgcn_rcpf(1.f + __expf(v));
          *(u16*)((char*)p.P + (unsigned)((row * INP + col) * 2)) = f2bf(v);
        }
    }
  } else if (EPI == EPI_Q) {
#pragma unroll
    for (int nb = 0; nb < 2; ++nb) {
      const int cblk = nt * (NWC * 2) + wc * 2 + nb;
      const bool ropeblk = (cblk % 3) == 2;
#pragma unroll
      for (int mb = 0; mb < MB; ++mb)
#pragma unroll
        for (int i = 0; i < 16; ++i) {
          const int rl = wr * WRS + mb * 32 + crow(i, lh);
          float v = acc[mb][nb][i] * rs[rl] * QSCALE;
          if (ropeblk && !isctx) {
            const float pv = dpp_f<0x128>(v);
            const int t = tt0 - CTXL + rl;
            const int pos = (lr & 16) ? (t & 63) : (t >> 6);
            const float2 cs = *(const float2*)(p.rope + (pos * 8 + (lr & 7)) * 2);
            v = (lr & 8) ? (v * cs.x + pv * cs.y) : (v * cs.x - pv * cs.y);
          }
          *(u16*)((char*)p.Q + (unsigned)(((mt * TM + rl) * 768 + cblk * 32 + lr) * 2)) = f2bf(v);
          if ((i & 7) == 7) __builtin_amdgcn_sched_barrier(0);
        }
    }
  } else if (EPI == EPI_KV) {
    const int head = (nt * NWC + wc) >> 1;
    if ((wc & 1) == 0) {
#pragma unroll
      for (int mb = 0; mb < MB; ++mb)
#pragma unroll
        for (int nb = 0; nb < 2; ++nb)
#pragma unroll
          for (int i = 0; i < 16; ++i) {
            const int rl = wr * WRS + mb * 32 + crow(i, lh);
            *(u16*)((char*)p.Kn + (unsigned)(((mt * TM + rl) * 512 + head * 64 + nb * 32 + lr) * 2)) = f2bf(acc[mb][nb][i] * rs[rl]);
          }
    } else {
#pragma unroll
      for (int mb = 0; mb < MB; ++mb)
#pragma unroll
        for (int nb = 0; nb < 2; ++nb)
#pragma unroll
          for (int g = 0; g < 4; ++g) {
            const int rl = wr * WRS + mb * 32 + 8 * g + 4 * lh;
            uint2 o;
            o.x = pack2(acc[mb][nb][4 * g] * rs[rl], acc[mb][nb][4 * g + 1] * rs[rl + 1]);
            o.y = pack2(acc[mb][nb][4 * g + 2] * rs[rl + 2], acc[mb][nb][4 * g + 3] * rs[rl + 3]);
            const int vd = nb * 32 + lr;
            *(uint2*)(p.Vt + ((size_t)(bidx * 8 + head) * 64 + vd) * TPB + tt0 + rl) = o;
          }
    }
  } else if (EPI == EPI_RES) {
    float* Hout = isctx ? p.Hc + ((size_t)bidx * CTXL + tt0) * DM : p.Hl + ((size_t)bidx * SEQ + tt0 - CTXL) * DM;
    const float* gate = p.mod + ((size_t)l * 17 + (isctx ? 16 : bidx)) * 6144 + gofs;
#pragma unroll
    for (int nb = 0; nb < 2; ++nb) {
      const int col = nt * TN + wc * 64 + nb * 32 + lr;
      const float gv = gate[col];
#pragma unroll
      for (int mb = 0; mb < MB; ++mb)
#pragma unroll
        for (int i = 0; i < 16; ++i) {
          const int rl = wr * WRS + mb * 32 + crow(i, lh);
          unsafeAtomicAdd((float*)((char*)Hout + (unsigned)((rl * DM + col) * 4)), gv * acc[mb][nb][i]);
          if ((i & 3) == 3) __builtin_amdgcn_sched_barrier(0);
        }
    }
  } else if (EPI == EPI_SWIGLU) {
#pragma unroll
    for (int mb = 0; mb < MB; ++mb)
#pragma unroll
      for (int i = 0; i < 16; ++i) {
        const int row = mt * TM + wr * WRS + mb * 32 + crow(i, lh);
        const float a = acc[mb][0][i], b = acc[mb][1][i];
        *(u16*)((char*)p.P + (unsigned)((row * FFH + (nt * NWC + wc) * 32 + lr) * 2)) = f2bf(siluf(a) * b);
      }
  }
}

template <int EPI, bool RSQ, bool DEEP>
DI void gemm_phase(const Params& p, int l, const u16* __restrict__ A, int lda, const u16* __restrict__ Bt, int K,
                   int ntiles_n, int gofs, char* smem, int vbid, int nvblk) {
  const int xcd = vbid & 7, lb = vbid >> 3, nlb = nvblk >> 3;
  constexpr int per = MT / 8;
  const int total = per * ntiles_n;
  auto decode = [&](int t, int& mt, int& nt) {
    const int grp = t / (8 * ntiles_n);
    const int rem = t - grp * 8 * ntiles_n;
    const int gsz = min(8, per - grp * 8);
    nt = rem / gsz;
    mt = per * xcd + grp * 8 + (rem - nt * gsz);
  };
  if (lb >= total) return;
  const int tid = opq(threadIdx.x & 255), lane = tid & 63, wid = tid >> 6, wr = wid >> 1, wc = wid & 1;
  const int lr = lane & 31, lh = lane >> 5;
  const int srow = tid >> 3, sch = tid & 7;
  const int nk = K >> 6;
  float* rs = (float*)(smem + 73728);
  int t = lb, mt, nt, kt = 0, cur = 0;
  decode(t, mt, nt);
  int Lt = lb, Lkt = 0;
  bool Lvalid = true;
  const u16* LA = A + (size_t)(mt * 128 + srow) * lda + sch * 8;
  const u16* LB = Bt + (size_t)(nt * 128 + srow) * K + sch * 8;
  auto issue = [&](u32x4 (&qa)[4], u32x4 (&qb)[4]) {
#pragma unroll
    for (int i = 0; i < 4; ++i) {
      qa[i] = *(const u32x4*)(LA + (size_t)(32 * i) * lda + Lkt * 64);
      qb[i] = *(const u32x4*)(LB + (size_t)(32 * i) * K + Lkt * 64);
    }
    if (++Lkt == nk) {
      Lkt = 0; Lt += nlb;
      if (Lt < total) {
        int a, b; decode(Lt, a, b);
        LA = A + (size_t)(a * 128 + srow) * lda + sch * 8;
        LB = Bt + (size_t)(b * 128 + srow) * K + sch * 8;
      } else Lvalid = false;
    }
  };
  float ssq[4] = {0.f, 0.f, 0.f, 0.f};
  auto stash = [&](u32x4 (&qa)[4], u32x4 (&qb)[4], int stage) {
    char* As = smem + stage * 36864;
    char* Bs = As + 18432;
#pragma unroll
    for (int i = 0; i < 4; ++i) {
      if (RSQ) { float f[8]; unpack8(qa[i], f);
#pragma unroll
        for (int e = 0; e < 8; ++e) ssq[i] = fmaf(f[e], f[e], ssq[i]); }
      *(u32x4*)(As + (srow + 32 * i) * 144 + sch * 16) = qa[i];
      *(u32x4*)(Bs + (srow + 32 * i) * 144 + sch * 16) = qb[i];
    }
  };
  auto stash_part = [&](u32x4 (&qa)[4], u32x4 (&qb)[4], int stage, int i) {
    char* As = smem + stage * 36864;
    char* Bs = As + 18432;
    if (RSQ) { float f[8]; unpack8(qa[i], f);
#pragma unroll
      for (int e = 0; e < 8; ++e) ssq[i] = fmaf(f[e], f[e], ssq[i]); }
    *(u32x4*)(As + (srow + 32 * i) * 144 + sch * 16) = qa[i];
    *(u32x4*)(Bs + (srow + 32 * i) * 144 + sch * 16) = qb[i];
  };
  u32x4 ra0[4], rb0[4], ra1[4], rb1[4];
  f32x16 acc[2][2];
#pragma unroll
  for (int a = 0; a < 2; ++a)
#pragma unroll
    for (int b = 0; b < 2; ++b)
#pragma unroll
      for (int i = 0; i < 16; ++i) acc[a][b][i] = 0.f;
  issue(ra0, rb0);
  bool v1 = DEEP && Lvalid;
  if (v1) issue(ra1, rb1);
  stash(ra0, rb0, 0);
  __syncthreads();
  auto body = [&](u32x4 (&La)[4], u32x4 (&Lb)[4], bool& Lset_valid, u32x4 (&Sa)[4], u32x4 (&Sb)[4], const bool& Sset_valid) -> bool {
    const bool last = (kt == nk - 1);
    Lset_valid = Lvalid;
    if (Lset_valid) issue(La, Lb);
    {
      const char* As = smem + cur * 36864;
      const char* Bs = As + 18432;
      const char* ap = As + (wr * 64 + lr) * 144 + lh * 16;
      const char* bp = Bs + (wc * 64 + lr) * 144 + lh * 16;
      bf16x8 fa[2][2], fb[2][2];
      fa[0][0] = *(const bf16x8*)(ap);
      fb[0][0] = *(const bf16x8*)(bp);
      fb[0][1] = *(const bf16x8*)(bp + 32 * 144);
      fa[0][1] = *(const bf16x8*)(ap + 32 * 144);
#pragma unroll
      for (int ks = 0; ks < 4; ++ks) {
        const int cu = ks & 1, nx = cu ^ 1;
        if (ks < 3) {
          fa[nx][0] = *(const bf16x8*)(ap + (ks + 1) * 32);
          fb[nx][0] = *(const bf16x8*)(bp + (ks + 1) * 32);
          fb[nx][1] = *(const bf16x8*)(bp + 32 * 144 + (ks + 1) * 32);
          fa[nx][1] = *(const bf16x8*)(ap + 32 * 144 + (ks + 1) * 32);
        }
        __builtin_amdgcn_sched_barrier(0);
        __builtin_amdgcn_s_setprio(1);
        acc[0][0] = MFMA32(fa[cu][0], fb[cu][0], acc[0][0]);
        acc[0][1] = MFMA32(fa[cu][0], fb[cu][1], acc[0][1]);
        acc[1][0] = MFMA32(fa[cu][1], fb[cu][0], acc[1][0]);
        acc[1][1] = MFMA32(fa[cu][1], fb[cu][1], acc[1][1]);
        __builtin_amdgcn_s_setprio(0);
        __builtin_amdgcn_sched_barrier(0);
      }
    }
    if (last) {
      if (RSQ) {
#pragma unroll
        for (int i = 0; i < 4; ++i) {
          float v = ssq[i];
          v += dpp_f<0xB1>(v); v += dpp_f<0x4E>(v); v += dpp_f<0x141>(v);
          if (sch == 0) rs[srow + 32 * i] = rsqrtf(v / (float)K + 1e-6f);
          ssq[i] = 0.f;
        }
        __syncthreads();
      }
      gemm_epi<EPI, 2, 2>(p, l, acc, rs, mt, nt, gofs, wr, wc, lr, lh);
#pragma unroll
      for (int a = 0; a < 2; ++a)
#pragma unroll
        for (int b = 0; b < 2; ++b)
#pragma unroll
          for (int i = 0; i < 16; ++i) acc[a][b][i] = 0.f;
    }
    if (Sset_valid) stash(Sa, Sb, cur ^ 1);
    __syncthreads();
    cur ^= 1;
    if (last) {
      t += nlb;
      if (t >= total) return false;
      decode(t, mt, nt);
      kt = 0;
    } else {
      ++kt;
    }
    return true;
  };
  bool v0 = false;
#pragma unroll 1
  for (;;) {
    if (DEEP) {
      if (!body(ra0, rb0, v0, ra1, rb1, v1)) break;
      if (!body(ra1, rb1, v1, ra0, rb0, v0)) break;
    } else {
      if (!body(ra0, rb0, v0, ra0, rb0, v0)) break;
    }
  }
}

template <int EPI, bool RSQ>
DI void gemm_phase8(const Params& p, int l, const u16* __restrict__ A, int lda, const u16* __restrict__ Bt, int K,
                   int ntiles_n, int gofs, char* smem, bool latonly = false) {
  const int xcd = blockIdx.x & 7, lb = blockIdx.x >> 3, nlb = gridDim.x >> 3;
  constexpr bool DEEP = false;
  constexpr int perfull = (MROWS / 256) / 8;
  const int per = latonly ? 32 : perfull;
  const int total = per * ntiles_n;
  auto decode = [&](int t, int& mt, int& nt) {
    const int grp = t / (8 * ntiles_n);
    const int rem = t - grp * 8 * ntiles_n;
    const int gsz = min(8, per - grp * 8);
    nt = rem / gsz;
    const int m = grp * 8 + (rem - nt * gsz);
    mt = perfull * xcd + (latonly ? (m >> 4) * 17 + 1 + (m & 15) : m);
  };
  if (lb >= total) return;
  const int tid = opq(threadIdx.x), lane = tid & 63, wid = tid >> 6, wr = wid >> 2, wc = wid & 3;
  const int lr = lane & 31, lh = lane >> 5;
  const int srow = tid >> 3, sch = tid & 7;
  const int nk = K >> 6;
  float* rs = (float*)(smem + 147456);
  int t = lb, mt, nt, kt = 0, cur = 0;
  decode(t, mt, nt);
  int Lt = lb, Lkt = 0;
  bool Lvalid = true;
  unsigned LAo = (unsigned)((mt * 256 + srow) * lda + sch * 8) * 2u;
  unsigned LBo = (unsigned)((nt * 256 + srow) * K + sch * 8) * 2u;
  const unsigned strideA = (unsigned)(64 * lda) * 2u, strideB = (unsigned)(64 * K) * 2u;
  auto issue = [&](u32x4 (&qa)[4], u32x4 (&qb)[4]) {
#pragma unroll
    for (int i = 0; i < 4; ++i) {
      qa[i] = *(const u32x4*)((const char*)A + (LAo + i * strideA + (unsigned)Lkt * 128u));
      qb[i] = *(const u32x4*)((const char*)Bt + (LBo + i * strideB + (unsigned)Lkt * 128u));
    }
    if (++Lkt == nk) {
      Lkt = 0; Lt += nlb;
      if (Lt < total) {
        int a, b; decode(Lt, a, b);
        LAo = (unsigned)((a * 256 + srow) * lda + sch * 8) * 2u;
        LBo = (unsigned)((b * 256 + srow) * K + sch * 8) * 2u;
      } else Lvalid = false;
    }
  };
  float ssq[4] = {0.f, 0.f, 0.f, 0.f};
  auto stash = [&](u32x4 (&qa)[4], u32x4 (&qb)[4], int stage) {
    char* As = smem + stage * 73728;
    char* Bs = As + 36864;
#pragma unroll
    for (int i = 0; i < 4; ++i) {
      if (RSQ) { float f[8]; unpack8(qa[i], f);
#pragma unroll
        for (int e = 0; e < 8; ++e) ssq[i] = fmaf(f[e], f[e], ssq[i]); }
      *(u32x4*)(As + (srow + 64 * i) * 144 + sch * 16) = qa[i];
      *(u32x4*)(Bs + (srow + 64 * i) * 144 + sch * 16) = qb[i];
    }
  };
  auto stash_part = [&](u32x4 (&qa)[4], u32x4 (&qb)[4], int stage, int i) {
    char* As = smem + stage * 73728;
    char* Bs = As + 36864;
    if (RSQ) { float f[8]; unpack8(qa[i], f);
#pragma unroll
      for (int e = 0; e < 8; ++e) ssq[i] = fmaf(f[e], f[e], ssq[i]); }
    *(u32x4*)(As + (srow + 64 * i) * 144 + sch * 16) = qa[i];
    *(u32x4*)(Bs + (srow + 64 * i) * 144 + sch * 16) = qb[i];
  };
  u32x4 ra0[4], rb0[4], ra1[4], rb1[4];
  f32x16 acc[4][2];
#pragma unroll
  for (int a = 0; a < 4; ++a)
#pragma unroll
    for (int b = 0; b < 2; ++b)
#pragma unroll
      for (int i = 0; i < 16; ++i) acc[a][b][i] = 0.f;
  issue(ra0, rb0);
  bool v1 = DEEP && Lvalid;
  if (v1) issue(ra1, rb1);
  stash(ra0, rb0, 0);
  __syncthreads();
  auto body = [&](u32x4 (&La)[4], u32x4 (&Lb)[4], bool& Lset_valid, u32x4 (&Sa)[4], u32x4 (&Sb)[4], const bool& Sset_valid) -> bool {
    const bool last = (kt == nk - 1);
    Lset_valid = Lvalid;
    {
      const char* As = smem + cur * 73728;
      const char* Bs = As + 36864;
      const char* ap = As + (wr * 128 + lr) * 144 + lh * 16;
      const char* bp = Bs + (wc * 64 + lr) * 144 + lh * 16;
      bf16x8 fa[3][2], fb[2][2];
      fa[0][0] = *(const bf16x8*)(ap);
      fa[0][1] = *(const bf16x8*)(ap + 32 * 144);
      fb[0][0] = *(const bf16x8*)(bp);
      fb[0][1] = *(const bf16x8*)(bp + 32 * 144);
      fa[1][0] = *(const bf16x8*)(ap + 2 * 32 * 144);
      fa[1][1] = *(const bf16x8*)(ap + 3 * 32 * 144);
      fb[1][0] = *(const bf16x8*)(bp + 32);
      fb[1][1] = *(const bf16x8*)(bp + 32 * 144 + 32);
      __builtin_amdgcn_sched_barrier(0);
      if (Lset_valid) issue(La, Lb);
      __builtin_amdgcn_sched_barrier(0);
#pragma unroll
      for (int u = 0; u < 8; ++u) {
        const int ks = u >> 1, hf = u & 1, ca = u % 3, cb = ks & 1;
        if (u + 2 < 8) {
          const int ks2 = (u + 2) >> 1, hf2 = (u + 2) & 1, cn = (u + 2) % 3;
          fa[cn][0] = *(const bf16x8*)(ap + (2 * hf2) * 32 * 144 + ks2 * 32);
          fa[cn][1] = *(const bf16x8*)(ap + (2 * hf2 + 1) * 32 * 144 + ks2 * 32);
        }
        __builtin_amdgcn_sched_barrier(0);
        __builtin_amdgcn_s_setprio(1);
        acc[2 * hf][0] = MFMA32(fa[ca][0], fb[cb][0], acc[2 * hf][0]);
        acc[2 * hf][1] = MFMA32(fa[ca][0], fb[cb][1], acc[2 * hf][1]);
        acc[2 * hf + 1][0] = MFMA32(fa[ca][1], fb[cb][0], acc[2 * hf + 1][0]);
        acc[2 * hf + 1][1] = MFMA32(fa[ca][1], fb[cb][1], acc[2 * hf + 1][1]);
        __builtin_amdgcn_s_setprio(0);
        __builtin_amdgcn_sched_barrier(0);
        if (hf == 1 && ks + 2 < 4) {
          fb[cb][0] = *(const bf16x8*)(bp + (ks + 2) * 32);
          fb[cb][1] = *(const bf16x8*)(bp + 32 * 144 + (ks + 2) * 32);
          __builtin_amdgcn_sched_barrier(0);
        }
      }
    }
    if (last) {
      if (RSQ) {
#pragma unroll
        for (int i = 0; i < 4; ++i) {
          float v = ssq[i];
          v += dpp_f<0xB1>(v); v += dpp_f<0x4E>(v); v += dpp_f<0x141>(v);
          if (sch == 0) rs[srow + 64 * i] = rsqrtf(v / (float)K + 1e-6f);
          ssq[i] = 0.f;
        }
        __syncthreads();
      }
      gemm_epi<EPI, 4, 4>(p, l, acc, rs, mt, nt, gofs, wr, wc, lr, lh);
#pragma unroll
      for (int a = 0; a < 4; ++a)
#pragma unroll
        for (int b = 0; b < 2; ++b)
#pragma unroll
          for (int i = 0; i < 16; ++i) acc[a][b][i] = 0.f;
    }
    if (Sset_valid) stash(Sa, Sb, cur ^ 1);
    __syncthreads();
    cur ^= 1;
    if (last) {
      t += nlb;
      if (t >= total) return false;
      decode(t, mt, nt);
      kt = 0;
    } else {
      ++kt;
    }
    return true;
  };
  bool v0 = false;
#pragma unroll 1
  for (;;) {
    if (DEEP) {
      if (!body(ra0, rb0, v0, ra1, rb1, v1)) break;
      if (!body(ra1, rb1, v1, ra0, rb0, v0)) break;
    } else {
      if (!body(ra0, rb0, v0, ra0, rb0, v0)) break;
    }
  }
}

DI void krope_tile(const Params& p, int t) {
  const int tid = opq(threadIdx.x & 255);
  const int sub = tid & 15, axis = sub >> 3, f = sub & 7;
#pragma unroll 1
  for (int it = 0; it < 8; ++it) {
    const int row = t * 128 + it * 16 + (tid >> 4);
    const int tt = row % TPB;
    const u16* src = p.P + (size_t)row * INP + 640 + axis * 16 + f;
    float x1 = bf2f(src[0]), x2 = bf2f(src[8]);
    if (tt >= CTXL) {
      const int tl = tt - CTXL;
      const int pos = axis ? (tl & 63) : (tl >> 6);
      const float2 cs = *(const float2*)(p.rope + (pos * 8 + f) * 2);
      const float y1 = x1 * cs.x - x2 * cs.y, y2 = x2 * cs.x + x1 * cs.y;
      x1 = y1; x2 = y2;
    }
    u16* dst = p.KR + (size_t)row * 32 + axis * 16 + f;
    dst[0] = f2bf(x1); dst[8] = f2bf(x2);
  }
}

DI void hgrn_chain(const Params& p, int l, int cid, char* smem) {
  const int b = cid >> 3, hh = (cid >> 1) & 3, dir = cid & 1;
  const int tid = opq(threadIdx.x & 255), lane = tid & 63, w = tid >> 6, lr = lane & 31, lh = lane >> 5;
  const int pb = w >> 1, jb = w & 1;
  float* bm = (float*)smem;
  float* tot = bm + 4096;
  float* er = tot + 256;
  float* ed = er + 64;
  char* Qd = (char*)(ed + 64);
  char* Kd = Qd + 9216;
  char* Kt = Kd + 9216;
  char* Vt = Kt + 9216;
  const size_t rowbase = (size_t)b * TPB;
  auto ttlo_of = [&](int c) { return dir ? (c < 4 ? 192 - 64 * c : 4544 - 64 * c) : 64 * c; };
  const int r = tid >> 2, q4 = tid & 3;
  const int jst = dir ? 63 - r : r;
  u32x4 rq[2], rn[2], rv[2];
  auto load_regs = [&](int c) {
    const u16* src = p.P + (rowbase + ttlo_of(c) + r) * INP + O1 + hh * 64 + q4 * 16;
    rq[0] = *(const u32x4*)(src); rq[1] = *(const u32x4*)(src + 8);
    rn[0] = *(const u32x4*)(src + 256 + dir * 256); rn[1] = *(const u32x4*)(src + 256 + dir * 256 + 8);
    rv[0] = *(const u32x4*)(src + 768); rv[1] = *(const u32x4*)(src + 768 + 8);
  };
  f32x16 Sacc[2];
#pragma unroll
  for (int i = 0; i < 16; ++i) { Sacc[0][i] = 0.f; Sacc[1][i] = 0.f; }
  load_regs(0);
  constexpr int NCH = TPB / 64;
#pragma unroll 1
  for (int c = 0; c < NCH; ++c) {
    const int tl = ttlo_of(c);
    float qv[16], kv[16];
    {
      float nk[16], vv[16];
      unpack8(rq[0], qv); unpack8(rq[1], qv + 8);
      unpack8(rn[0], nk); unpack8(rn[1], nk + 8);
      unpack8(rv[0], vv); unpack8(rv[1], vv + 8);
      float g[16];
#pragma unroll
      for (int e = 0; e < 16; ++e) { kv[e] = -nk[e]; g[e] = __logf(fmaxf(1.f + nk[e], 2e-9f)); }
      float* gd = bm + jst * 64 + q4 * 16;
#pragma unroll
      for (int e4 = 0; e4 < 4; ++e4) *(float4*)(gd + 4 * e4) = make_float4(g[4 * e4], g[4 * e4 + 1], g[4 * e4 + 2], g[4 * e4 + 3]);
#pragma unroll
      for (int e = 0; e < 16; ++e) *(u16*)(Vt + (q4 * 16 + e) * 144 + jst * 2) = f2bf(vv[e]);
    }
    if (c + 1 < NCH) load_regs(c + 1);
    __syncthreads();
    {
      const int kc = tid & 63, qt = tid >> 6;
      float loc[16];
#pragma unroll
      for (int i = 0; i < 16; ++i) loc[i] = bm[(16 * qt + i) * 64 + kc];
#pragma unroll
      for (int i = 1; i < 16; ++i) loc[i] += loc[i - 1];
      tot[qt * 64 + kc] = loc[15];
      __syncthreads();
      float off = 0.f;
#pragma unroll
      for (int q = 0; q < 3; ++q) if (q < qt) off += tot[q * 64 + kc];
#pragma unroll
      for (int i = 0; i < 16; ++i) bm[(16 * qt + i) * 64 + kc] = loc[i] + off;
    }
    __syncthreads();
    {
      const float* bj = bm + jst * 64 + q4 * 16;
      const float* br = bm + 31 * 64 + q4 * 16;
      unsigned qo[8], ko[8];
      float qdv[16], kd[16];
#pragma unroll
      for (int e = 0; e < 16; ++e) {
        const float d = bj[e] - br[e];
        qdv[e] = qv[e] * __expf(d);
        kd[e] = kv[e] * __expf(-d);
      }
#pragma unroll
      for (int e = 0; e < 8; ++e) { qo[e] = pack2(qdv[2 * e], qdv[2 * e + 1]); ko[e] = pack2(kd[2 * e], kd[2 * e + 1]); }
      *(u32x4*)(Qd + jst * 144 + q4 * 32) = (u32x4){qo[0], qo[1], qo[2], qo[3]};
      *(u32x4*)(Qd + jst * 144 + q4 * 32 + 16) = (u32x4){qo[4], qo[5], qo[6], qo[7]};
      *(u32x4*)(Kd + jst * 144 + q4 * 32) = (u32x4){ko[0], ko[1], ko[2], ko[3]};
      *(u32x4*)(Kd + jst * 144 + q4 * 32 + 16) = (u32x4){ko[4], ko[5], ko[6], ko[7]};
#pragma unroll
      for (int e = 0; e < 16; ++e) *(u16*)(Kt + (q4 * 16 + e) * 144 + jst * 2) = f2bf(kd[e]);
      if (tid < 64) {
        const float r31 = bm[31 * 64 + tid];
        er[tid] = __expf(r31);
        ed[tid] = __expf(bm[63 * 64 + tid] - r31);
      }
    }
    __syncthreads();
    {
      const int jg = 32 * jb + lr;
      bf16x8 qfr[4];
#pragma unroll
      for (int ks = 0; ks < 4; ++ks) qfr[ks] = *(const bf16x8*)(Qd + jg * 144 + ks * 32 + lh * 16);
      f32x16 st[2];
#pragma unroll
      for (int i = 0; i < 16; ++i) { st[0][i] = 0.f; st[1][i] = 0.f; }
#pragma unroll
      for (int sb = 0; sb < 2; ++sb)
#pragma unroll
        for (int ks = 0; ks < 4; ++ks) {
          const bf16x8 kfr = *(const bf16x8*)(Kd + (32 * sb + lr) * 144 + ks * 32 + lh * 16);
          st[sb] = MFMA32(kfr, qfr[ks], st[sb]);
        }
      f32x16 acc;
#pragma unroll
      for (int i = 0; i < 16; ++i) acc[i] = 0.f;
#pragma unroll
      for (int nb = 0; nb < 2; ++nb) {
#pragma unroll
        for (int g = 0; g < 4; ++g) {
          const float4 e4 = *(const float4*)(er + 32 * nb + 8 * g + 4 * lh);
          Sacc[nb][4 * g] *= e4.x; Sacc[nb][4 * g + 1] *= e4.y; Sacc[nb][4 * g + 2] *= e4.z; Sacc[nb][4 * g + 3] *= e4.w;
        }
#pragma unroll
        for (int s2 = 0; s2 < 2; ++s2) {
          u32x4 pk;
          pk.x = pack2(Sacc[nb][8 * s2 + 0], Sacc[nb][8 * s2 + 1]);
          pk.y = pack2(Sacc[nb][8 * s2 + 2], Sacc[nb][8 * s2 + 3]);
          pk.z = pack2(Sacc[nb][8 * s2 + 4], Sacc[nb][8 * s2 + 5]);
          pk.w = pack2(Sacc[nb][8 * s2 + 6], Sacc[nb][8 * s2 + 7]);
          const char* cp = Qd + jg * 144 + (32 * nb + 16 * s2 + 4 * lh) * 2;
          const uint2 c0 = *(const uint2*)(cp);
          const uint2 c1 = *(const uint2*)(cp + 16);
          const bf16x8 qperm = __builtin_bit_cast(bf16x8, ((u32x4){c0.x, c0.y, c1.x, c1.y}));
          acc = MFMA32(__builtin_bit_cast(bf16x8, pk), qperm, acc);
        }
      }
#pragma unroll
      for (int sb = 0; sb < 2; ++sb) {
#pragma unroll
        for (int i = 0; i < 16; ++i) {
          const int sg = 32 * sb + crow(i, lh);
          st[sb][i] = (sg <= jg) ? st[sb][i] : 0.f;
        }
#pragma unroll
        for (int s2 = 0; s2 < 2; ++s2) {
          u32x4 pk;
          pk.x = pack2(st[sb][8 * s2 + 0], st[sb][8 * s2 + 1]);
          pk.y = pack2(st[sb][8 * s2 + 2], st[sb][8 * s2 + 3]);
          pk.z = pack2(st[sb][8 * s2 + 4], st[sb][8 * s2 + 5]);
          pk.w = pack2(st[sb][8 * s2 + 6], st[sb][8 * s2 + 7]);
          const char* xp = Vt + (32 * pb + lr) * 144 + (32 * sb + 16 * s2 + 4 * lh) * 2;
          const uint2 x0 = *(const uint2*)(xp);
          const uint2 x1 = *(const uint2*)(xp + 16);
          const bf16x8 vfr = __builtin_bit_cast(bf16x8, ((u32x4){x0.x, x0.y, x1.x, x1.y}));
          acc = MFMA32(vfr, __builtin_bit_cast(bf16x8, pk), acc);
        }
      }
      {
        const int tt = dir ? tl + 63 - jg : tl + jg;
        u16* op = p.RO + (rowbase + tt) * 512 + dir * 256 + hh * 64 + 32 * pb + 4 * lh;
#pragma unroll
        for (int g = 0; g < 4; ++g) {
          uint2 o;
          o.x = pack2(acc[4 * g], acc[4 * g + 1]);
          o.y = pack2(acc[4 * g + 2], acc[4 * g + 3]);
          *(uint2*)(op + 8 * g) = o;
        }
      }
#pragma unroll
      for (int nb = 0; nb < 2; ++nb) {
#pragma unroll
        for (int ks = 0; ks < 4; ++ks) {
          const bf16x8 afr = *(const bf16x8*)(Kt + (32 * nb + lr) * 144 + ks * 32 + lh * 16);
          const bf16x8 bfr = *(const bf16x8*)(Vt + (32 * pb + lr) * 144 + ks * 32 + lh * 16);
          Sacc[nb] = MFMA32(afr, bfr, Sacc[nb]);
        }
#pragma unroll
        for (int g = 0; g < 4; ++g) {
          const float4 e4 = *(const float4*)(ed + 32 * nb + 8 * g + 4 * lh);
          Sacc[nb][4 * g] *= e4.x; Sacc[nb][4 * g + 1] *= e4.y; Sacc[nb][4 * g + 2] *= e4.z; Sacc[nb][4 * g + 3] *= e4.w;
        }
      }
    }
    __syncthreads();
  }
}

DI void ssmprep_tile(const Params& p, int l, int t) {
  const int tid_ = opq(threadIdx.x & 255); const int lane = tid_ & 63, wid = tid_ >> 6;
  const int c8 = lane * 8;
  float cw[5][8], cb[8];
#pragma unroll
  for (int e = 0; e < 8; ++e) {
    cb[e] = p.conv_b[l * 512 + c8 + e];
#pragma unroll
    for (int j = 0; j < 5; ++j) cw[j][e] = p.conv_w[((size_t)l * 5 + j) * 512 + c8 + e];
  }
  const int dcol = (c8 < 256) ? 768 + c8 : ((c8 < 384) ? 512 + (c8 - 256) : 640 + (c8 - 384));
  float dtb = 0.f, An = 0.f;
  if (lane < 8) { dtb = p.dt_bias[l * 8 + lane]; An = -expf(p.a_log[l * 8 + lane]); }
#pragma unroll 2
  for (int rr = 0; rr < 8; ++rr) {
    const int row = t * 32 + wid * 8 + rr;
    const int tt = row % TPB;
    const int seglo = (tt < CTXL) ? 0 : CTXL, seghi = (tt < CTXL) ? CTXL : TPB;
    const u16* Pr = p.P + (size_t)row * INP + O2 + 256 + c8;
    float a[8];
#pragma unroll
    for (int e = 0; e < 8; ++e) a[e] = cb[e];
#pragma unroll
    for (int j = 0; j < 5; ++j) {
      const int t2 = tt + j - 2;
      if (t2 >= seglo && t2 < seghi) {
        const u32x4 u = *(const u32x4*)(Pr + (ptrdiff_t)(j - 2) * INP);
        float f[8]; unpack8(u, f);
#pragma unroll
        for (int e = 0; e < 8; ++e) a[e] = fmaf(cw[j][e], f[e], a[e]);
      }
    }
    uint4 ov;
    ov.x = pack2(siluf(a[0]), siluf(a[1])); ov.y = pack2(siluf(a[2]), siluf(a[3]));
    ov.z = pack2(siluf(a[4]), siluf(a[5])); ov.w = pack2(siluf(a[6]), siluf(a[7]));
    *(uint4*)(p.ACT + (size_t)row * DM + dcol) = ov;
    if (lane < 8) {
      const float dr = bf2f(p.P[(size_t)row * INP + O2 + 768 + lane]) + dtb;
      const float dt = (dr > 20.f) ? dr : log1pf(expf(dr));
      p.DTA[(size_t)row * 16 + lane] = dt;
      p.DTA[(size_t)row * 16 + 8 + lane] = An * dt;
    }
  }
}

DI void ssm_chain(const Params& p, int l, int cid, char* smem) {
  const int b = cid >> 3, hh = (cid >> 1) & 3, dir = cid & 1, grp = hh >> 1;
  const int tid = opq(threadIdx.x & 255), lane = tid & 63, w = tid >> 6, lr = lane & 31, lh = lane >> 5;
  const int pb = w >> 1, jb = w & 1;
  char* Cq = smem;
  char* Bk = Cq + 9216;
  char* Btr = Bk + 9216;
  char* XT = Btr + 9216;
  char* XTs = XT + 8704;
  float* csm = (float*)(XTs + 9216);
  const size_t rowbase = (size_t)b * TPB;
  auto ttlo_of = [&](int c) { return dir ? (c < 4 ? 192 - 64 * c : 4544 - 64 * c) : 64 * c; };
  const int r = tid >> 2, q4 = tid & 3;
  const int jst = dir ? 63 - r : r;
  u32x4 rx[2], rB[2], rC[2];
  float rdt;
  auto load_regs = [&](int c) {
    const size_t row = rowbase + ttlo_of(c) + r;
    const u16* src = p.ACT + row * DM;
    rx[0] = *(const u32x4*)(src + 768 + hh * 64 + q4 * 16); rx[1] = *(const u32x4*)(src + 768 + hh * 64 + q4 * 16 + 8);
    rB[0] = *(const u32x4*)(src + 512 + grp * 64 + q4 * 16); rB[1] = *(const u32x4*)(src + 512 + grp * 64 + q4 * 16 + 8);
    rC[0] = *(const u32x4*)(src + 640 + grp * 64 + q4 * 16); rC[1] = *(const u32x4*)(src + 640 + grp * 64 + q4 * 16 + 8);
    rdt = p.DTA[row * 16 + dir * 4 + hh];
  };
  f32x16 Sacc[2];
#pragma unroll
  for (int i = 0; i < 16; ++i) { Sacc[0][i] = 0.f; Sacc[1][i] = 0.f; }
  load_regs(0);
  constexpr int NCH = TPB / 64;
#pragma unroll 1
  for (int c = 0; c < NCH; ++c) {
    const int tl = ttlo_of(c);
    if (w == 0) {
      const int tt = dir ? tl + 63 - lane : tl + lane;
      float a = p.DTA[(rowbase + tt) * 16 + 8 + dir * 4 + hh];
#pragma unroll
      for (int o = 1; o < 64; o <<= 1) { const float t = __shfl_up(a, o); if (lane >= o) a += t; }
      csm[lane] = a;
    }
    __syncthreads();
    {
      const float wj = __expf(csm[63] - csm[jst]);
      *(u32x4*)(Cq + jst * 144 + q4 * 32) = rC[0]; *(u32x4*)(Cq + jst * 144 + q4 * 32 + 16) = rC[1];
      *(u32x4*)(Bk + jst * 144 + q4 * 32) = rB[0]; *(u32x4*)(Bk + jst * 144 + q4 * 32 + 16) = rB[1];
      float xb[16], bb[16];
      unpack8(rx[0], xb); unpack8(rx[1], xb + 8);
      unpack8(rB[0], bb); unpack8(rB[1], bb + 8);
#pragma unroll
      for (int e = 0; e < 16; ++e) {
        const int ch = q4 * 16 + e;
        const float xd = xb[e] * rdt;
        *(u16*)(Btr + ch * 144 + jst * 2) = f2bf(bb[e]);
        *(u16*)(XT + ch * 136 + jst * 2) = f2bf(xd);
        *(u16*)(XTs + ch * 144 + jst * 2) = f2bf(xd * wj);
      }
    }
    if (c + 1 < NCH) load_regs(c + 1);
    __syncthreads();
    {
      const int jg = 32 * jb + lr;
      const float csj = csm[jg];
      const float decay_all = __expf(csm[63]);
      bf16x8 cfr[4];
#pragma unroll
      for (int ks = 0; ks < 4; ++ks) cfr[ks] = *(const bf16x8*)(Cq + jg * 144 + ks * 32 + lh * 16);
      f32x16 st[2];
#pragma unroll
      for (int i = 0; i < 16; ++i) { st[0][i] = 0.f; st[1][i] = 0.f; }
#pragma unroll
      for (int sb = 0; sb < 2; ++sb)
#pragma unroll
        for (int ks = 0; ks < 4; ++ks) {
          const bf16x8 bfr = *(const bf16x8*)(Bk + (32 * sb + lr) * 144 + ks * 32 + lh * 16);
          st[sb] = MFMA32(bfr, cfr[ks], st[sb]);
        }
      f32x16 acc2;
#pragma unroll
      for (int i = 0; i < 16; ++i) acc2[i] = 0.f;
#pragma unroll
      for (int nb = 0; nb < 2; ++nb)
#pragma unroll
        for (int s2 = 0; s2 < 2; ++s2) {
          u32x4 pk;
          pk.x = pack2(Sacc[nb][8 * s2 + 0], Sacc[nb][8 * s2 + 1]);
          pk.y = pack2(Sacc[nb][8 * s2 + 2], Sacc[nb][8 * s2 + 3]);
          pk.z = pack2(Sacc[nb][8 * s2 + 4], Sacc[nb][8 * s2 + 5]);
          pk.w = pack2(Sacc[nb][8 * s2 + 6], Sacc[nb][8 * s2 + 7]);
          const char* cp = Cq + jg * 144 + (32 * nb + 16 * s2 + 4 * lh) * 2;
          const uint2 c0 = *(const uint2*)(cp);
          const uint2 c1 = *(const uint2*)(cp + 16);
          const bf16x8 cperm = __builtin_bit_cast(bf16x8, ((u32x4){c0.x, c0.y, c1.x, c1.y}));
          acc2 = MFMA32(__builtin_bit_cast(bf16x8, pk), cperm, acc2);
        }
      f32x16 acc;
#pragma unroll
      for (int i = 0; i < 16; ++i) acc[i] = 0.f;
#pragma unroll
      for (int sb = 0; sb < 2; ++sb) {
#pragma unroll
        for (int g = 0; g < 4; ++g) {
          const float4 c4 = *(const float4*)(csm + 32 * sb + 8 * g + 4 * lh);
          const float cv[4] = {c4.x, c4.y, c4.z, c4.w};
#pragma unroll
          for (int e = 0; e < 4; ++e) {
            const int sg = 32 * sb + 8 * g + 4 * lh + e;
            const float f = __expf(csj - cv[e]);
            st[sb][4 * g + e] = (sg <= jg) ? st[sb][4 * g + e] * f : 0.f;
          }
        }
#pragma unroll
        for (int s2 = 0; s2 < 2; ++s2) {
          u32x4 pk;
          pk.x = pack2(st[sb][8 * s2 + 0], st[sb][8 * s2 + 1]);
          pk.y = pack2(st[sb][8 * s2 + 2], st[sb][8 * s2 + 3]);
          pk.z = pack2(st[sb][8 * s2 + 4], st[sb][8 * s2 + 5]);
          pk.w = pack2(st[sb][8 * s2 + 6], st[sb][8 * s2 + 7]);
          const char* xp = XT + (32 * pb + lr) * 136 + (32 * sb + 16 * s2 + 4 * lh) * 2;
          const uint2 x0 = *(const uint2*)(xp);
          const uint2 x1 = *(const uint2*)(xp + 16);
          const bf16x8 xfr = __builtin_bit_cast(bf16x8, ((u32x4){x0.x, x0.y, x1.x, x1.y}));
          acc = MFMA32(xfr, __builtin_bit_cast(bf16x8, pk), acc);
        }
      }
      {
        const float ej = __expf(csj);
        const int tt = dir ? tl + 63 - jg : tl + jg;
        u16* op = p.RY + (rowbase + tt) * 512 + dir * 256 + hh * 64 + 32 * pb + 4 * lh;
#pragma unroll
        for (int g = 0; g < 4; ++g) {
          uint2 o;
          o.x = pack2(acc[4 * g] + ej * acc2[4 * g], acc[4 * g + 1] + ej * acc2[4 * g + 1]);
          o.y = pack2(acc[4 * g + 2] + ej * acc2[4 * g + 2], acc[4 * g + 3] + ej * acc2[4 * g + 3]);
          *(uint2*)(op + 8 * g) = o;
        }
      }
#pragma unroll
      for (int nb = 0; nb < 2; ++nb) {
#pragma unroll
        for (int i = 0; i < 16; ++i) Sacc[nb][i] *= decay_all;
#pragma unroll
        for (int ks = 0; ks < 4; ++ks) {
          const bf16x8 afr = *(const bf16x8*)(Btr + (32 * nb + lr) * 144 + ks * 32 + lh * 16);
          const bf16x8 bfr = *(const bf16x8*)(XTs + (32 * pb + lr) * 144 + ks * 32 + lh * 16);
          Sacc[nb] = MFMA32(afr, bfr, Sacc[nb]);
        }
      }
    }
    __syncthreads();
  }
}

DI void readout_tile(const Params& p, int l, int t) {
  const int tid_ = opq(threadIdx.x & 255); const int lane = tid_ & 63, wid = tid_ >> 6;
  const int c4 = lane * 4;
  float hg[4], sg[4], dsk;
#pragma unroll
  for (int e = 0; e < 4; ++e) {
    hg[e] = p.hg_norm_g[l * 256 + c4 + e];
    sg[e] = p.ssm_norm_g[l * 256 + c4 + e];
  }
  dsk = p.ssm_d[l * 4 + (lane >> 4)];
#pragma unroll 2
  for (int rr = 0; rr < 8; ++rr) {
    const int row = t * 32 + wid * 8 + rr;
    const int tt = row % TPB;
    const u16* Pr = p.P + (size_t)row * INP;
    {
      const uint2 of = *(const uint2*)(p.RO + (size_t)row * 512 + c4);
      const uint2 obk = *(const uint2*)(p.RO + (size_t)row * 512 + 256 + c4);
      const uint2 og = *(const uint2*)(Pr + O1 + 1024 + c4);
      float o[4] = {lo2f(of.x) + lo2f(obk.x), hi2f(of.x) + hi2f(obk.x), lo2f(of.y) + lo2f(obk.y), hi2f(of.y) + hi2f(obk.y)};
      float ss = o[0] * o[0] + o[1] * o[1] + o[2] * o[2] + o[3] * o[3];
      ss = row_sum16(ss);
      const float r = rsqrtf(ss * (1.f / 64.f) + 1e-6f);
      const float g[4] = {lo2f(og.x), hi2f(og.x), lo2f(og.y), hi2f(og.y)};
      uint2 ov;
      ov.x = pack2(o[0] * r * hg[0] * siluf(g[0]), o[1] * r * hg[1] * siluf(g[1]));
      ov.y = pack2(o[2] * r * hg[2] * siluf(g[2]), o[3] * r * hg[3] * siluf(g[3]));
      *(uint2*)(p.ACT + (size_t)row * DM + 512 + c4) = ov;
    }
    {
      const uint2 yf = *(const uint2*)(p.RY + (size_t)row * 512 + c4);
      const uint2 yb = *(const uint2*)(p.RY + (size_t)row * 512 + 256 + c4);
      const uint2 zz = *(const uint2*)(Pr + O2 + c4);
      const uint2 xc = *(const uint2*)(p.ACT + (size_t)row * DM + 768 + c4);
      const float a[4] = {lo2f(xc.x), hi2f(xc.x), lo2f(xc.y), hi2f(xc.y)};
      const float z[4] = {lo2f(zz.x), hi2f(zz.x), lo2f(zz.y), hi2f(zz.y)};
      const float yy[4] = {lo2f(yf.x) + lo2f(yb.x), hi2f(yf.x) + hi2f(yb.x), lo2f(yf.y) + lo2f(yb.y), hi2f(yf.y) + hi2f(yb.y)};
      float v[4], ss = 0.f;
#pragma unroll
      for (int e = 0; e < 4; ++e) { v[e] = (yy[e] + dsk * a[e]) * siluf(z[e]); ss = fmaf(v[e], v[e], ss); }
      ss = row_sum16(ss);
      {
        const float lo = rdlane(ss, 0) + rdlane(ss, 16), hi = rdlane(ss, 32) + rdlane(ss, 48);
        ss = (lane < 32) ? lo : hi;
      }
      const float r = rsqrtf(ss * (1.f / 128.f) + 1e-6f);
      uint2 ov;
      ov.x = pack2(v[0] * r * sg[0], v[1] * r * sg[1]);
      ov.y = pack2(v[2] * r * sg[2], v[3] * r * sg[3]);
      *(uint2*)(p.ACT + (size_t)row * DM + 768 + c4) = ov;
    }
  }
}

DI void attn_tile(const Params& p, int bh, int qt, char* smem) {
  const int b = bh >> 3, hh = bh & 7;
  const int nkt = (qt < 2) ? 4 : 68;
  const int tid = opq(threadIdx.x), lane = tid & 63, w = tid >> 6, lr = lane & 31, lh = lane >> 5;
  const size_t rowbase = (size_t)b * TPB;
  const size_t qrow = rowbase + qt * 128 + w * 32 + lr;
  bf16x8 qf[6];
  {
    const u16* qp = p.Q + qrow * 768 + hh * 96 + lh * 8;
#pragma unroll
    for (int s = 0; s < 6; ++s) qf[s] = *(const bf16x8*)(qp + 16 * s);
  }
  u32x4 rk[3], rv[2];
  auto load_tiles = [&](int kt) {
#pragma unroll
    for (int i = 0; i < 3; ++i) {
      const int idx = tid + 256 * i, key = idx / 12, ch = idx % 12;
      const size_t kr = rowbase + kt * 64 + key;
      rk[i] = (ch < 8) ? *(const u32x4*)(p.Kn + kr * 512 + hh * 64 + ch * 8) : *(const u32x4*)(p.KR + kr * 32 + (ch - 8) * 8);
    }
#pragma unroll
    for (int i = 0; i < 2; ++i) {
      const int idx = tid + 256 * i, vd = idx >> 3, ch = idx & 7;
      rv[i] = *(const u32x4*)(p.Vt + ((size_t)bh * 64 + vd) * TPB + kt * 64 + ch * 8);
    }
  };
  auto store_tiles = [&](int st) {
    char* Ks = smem + st * 22016;
    char* Vs = Ks + 13312;
#pragma unroll
    for (int i = 0; i < 3; ++i) {
      const int idx = tid + 256 * i, key = idx / 12, ch = idx % 12;
      *(u32x4*)(Ks + key * 208 + ch * 16) = rk[i];
    }
#pragma unroll
    for (int i = 0; i < 2; ++i) {
      const int idx = tid + 256 * i, vd = idx >> 3, ch = idx & 7;
      uint2* d = (uint2*)(Vs + vd * 136 + ch * 16);
      d[0] = make_uint2(rv[i].x, rv[i].y);
      d[1] = make_uint2(rv[i].z, rv[i].w);
    }
  };
  f32x16 O[2];
#pragma unroll
  for (int i = 0; i < 16; ++i) { O[0][i] = 0.f; O[1][i] = 0.f; }
  float m = -1e30f, lsum = 0.f;
  load_tiles(0);
  store_tiles(0);
  __syncthreads();
#pragma unroll 1
  for (int kt = 0; kt < nkt; ++kt) {
    const bool more = kt + 1 < nkt;
    if (more) load_tiles(kt + 1);
    const char* Ks = smem + (kt & 1) * 22016;
    const char* Vs = Ks + 13312;
    f32x16 st[2];
#pragma unroll
    for (int i = 0; i < 16; ++i) { st[0][i] = 0.f; st[1][i] = 0.f; }
    {
      bf16x8 kf[2][6];
#pragma unroll
      for (int kb = 0; kb < 2; ++kb)
#pragma unroll
        for (int s = 0; s < 6; ++s) kf[kb][s] = *(const bf16x8*)(Ks + (kb * 32 + lr) * 208 + s * 32 + lh * 16);
      __builtin_amdgcn_s_setprio(1);
#pragma unroll
      for (int s = 0; s < 6; ++s) {
        st[0] = MFMA32(kf[0][s], qf[s], st[0]);
        st[1] = MFMA32(kf[1][s], qf[s], st[1]);
      }
      __builtin_amdgcn_s_setprio(0);
    }
    u32x4 vf[2][2][2];
#pragma unroll
    for (int kb = 0; kb < 2; ++kb)
#pragma unroll
      for (int s2 = 0; s2 < 2; ++s2)
#pragma unroll
        for (int vb = 0; vb < 2; ++vb) {
          const char* vp = Vs + (vb * 32 + lr) * 136 + (kb * 32 + 16 * s2 + 4 * lh) * 2;
          const uint2 v0 = *(const uint2*)(vp);
          const uint2 v1 = *(const uint2*)(vp + 16);
          vf[kb][s2][vb] = (u32x4){v0.x, v0.y, v1.x, v1.y};
        }
    float mx = st[0][0];
#pragma unroll
    for (int i = 1; i < 16; ++i) mx = fmaxf(mx, st[0][i]);
#pragma unroll
    for (int i = 0; i < 16; ++i) mx = fmaxf(mx, st[1][i]);
    mx = fmaxf(mx, __shfl_xor(mx, 32));
    const float mn = fmaxf(m, mx);
    const float alpha = __builtin_amdgcn_exp2f(m - mn);
    m = mn;
    float ps = 0.f;
#pragma unroll
    for (int kb = 0; kb < 2; ++kb)
#pragma unroll
      for (int i = 0; i < 16; ++i) { st[kb][i] = __builtin_amdgcn_exp2f(st[kb][i] - mn); ps += st[kb][i]; }
    lsum = lsum * alpha + ps;
#pragma unroll
    for (int i = 0; i < 16; ++i) { O[0][i] *= alpha; O[1][i] *= alpha; }
#pragma unroll
    for (int kb = 0; kb < 2; ++kb)
#pragma unroll
      for (int s2 = 0; s2 < 2; ++s2) {
        u32x4 pk;
        pk.x = pack2(st[kb][8 * s2 + 0], st[kb][8 * s2 + 1]);
        pk.y = pack2(st[kb][8 * s2 + 2], st[kb][8 * s2 + 3]);
        pk.z = pack2(st[kb][8 * s2 + 4], st[kb][8 * s2 + 5]);
        pk.w = pack2(st[kb][8 * s2 + 6], st[kb][8 * s2 + 7]);
        const bf16x8 bfrag = __builtin_bit_cast(bf16x8, pk);
        O[0] = MFMA32(__builtin_bit_cast(bf16x8, vf[kb][s2][0]), bfrag, O[0]);
        O[1] = MFMA32(__builtin_bit_cast(bf16x8, vf[kb][s2][1]), bfrag, O[1]);
      }
    if (more) store_tiles((kt + 1) & 1);
    __syncthreads();
  }
  const float ltot = lsum + __shfl_xor(lsum, 32);
  const float inv = 1.f / ltot;
  u16* op = p.ACT + qrow * DM + hh * 64;
#pragma unroll
  for (int vb = 0; vb < 2; ++vb)
#pragma unroll
    for (int g = 0; g < 4; ++g) {
      uint2 o;
      o.x = pack2(O[vb][4 * g] * inv, O[vb][4 * g + 1] * inv);
      o.y = pack2(O[vb][4 * g + 2] * inv, O[vb][4 * g + 3] * inv);
      *(uint2*)(op + vb * 32 + 8 * g + 4 * lh) = o;
    }
}

DI void attn_tile8(const Params& p, int bh, int qt, char* smem) {
  const int b = bh >> 3, hh = bh & 7;
  const int nkt = (qt < 1) ? 2 : 34;
  const int tid = opq(threadIdx.x), lane = tid & 63, w = tid >> 6, lr = lane & 31, lh = lane >> 5;
  const size_t rowbase = (size_t)b * TPB;
  const size_t qrow = rowbase + qt * 256 + w * 32 + lr;
  constexpr int STAGE = 43520, VOFF = 26624, VROW = 264;
  bf16x8 qf[6];
  {
    const u16* qp = p.Q + qrow * 768 + hh * 96 + lh * 8;
#pragma unroll
    for (int s = 0; s < 6; ++s) qf[s] = *(const bf16x8*)(qp + 16 * s);
  }
  u32x4 rk[3], rv[2];
  auto load_tiles = [&](int kt) {
#pragma unroll
    for (int i = 0; i < 3; ++i) {
      const int idx = tid + 512 * i, key = idx / 12, ch = idx % 12;
      const size_t kr = rowbase + kt * 128 + key;
      rk[i] = (ch < 8) ? *(const u32x4*)(p.Kn + kr * 512 + hh * 64 + ch * 8) : *(const u32x4*)(p.KR + kr * 32 + (ch - 8) * 8);
    }
#pragma unroll
    for (int i = 0; i < 2; ++i) {
      const int idx = tid + 512 * i, vd = idx >> 4, ch = idx & 15;
      rv[i] = *(const u32x4*)(p.Vt + ((size_t)bh * 64 + vd) * TPB + kt * 128 + ch * 8);
    }
  };
  auto store_tiles = [&](int st) {
    char* Ks = smem + st * STAGE;
    char* Vs = Ks + VOFF;
#pragma unroll
    for (int i = 0; i < 3; ++i) {
      const int idx = tid + 512 * i, key = idx / 12, ch = idx % 12;
      *(u32x4*)(Ks + key * 208 + ch * 16) = rk[i];
    }
#pragma unroll
    for (int i = 0; i < 2; ++i) {
      const int idx = tid + 512 * i, vd = idx >> 4, ch = idx & 15;
      uint2* d = (uint2*)(Vs + vd * VROW + ch * 16);
      d[0] = make_uint2(rv[i].x, rv[i].y);
      d[1] = make_uint2(rv[i].z, rv[i].w);
    }
  };
  f32x16 O[2];
#pragma unroll
  for (int i = 0; i < 16; ++i) { O[0][i] = 0.f; O[1][i] = 0.f; }
  float m = -1e30f, lsum = 0.f;
  load_tiles(0);
  store_tiles(0);
  __syncthreads();
#pragma unroll 1
  for (int kt = 0; kt < nkt; ++kt) {
    const bool more = kt + 1 < nkt;
    if (more) load_tiles(kt + 1);
    const char* Ks = smem + (kt & 1) * STAGE;
    const char* Vs = Ks + VOFF;
    f32x16 st[4];
#pragma unroll
    for (int kb = 0; kb < 4; ++kb)
#pragma unroll
      for (int i = 0; i < 16; ++i) st[kb][i] = 0.f;
    {
      bf16x8 kf[2][4];
#pragma unroll
      for (int kb = 0; kb < 4; ++kb) kf[0][kb] = *(const bf16x8*)(Ks + (kb * 32 + lr) * 208 + lh * 16);
#pragma unroll
      for (int s = 0; s < 6; ++s) {
        if (s < 5) {
#pragma unroll
          for (int kb = 0; kb < 4; ++kb) kf[(s + 1) & 1][kb] = *(const bf16x8*)(Ks + (kb * 32 + lr) * 208 + (s + 1) * 32 + lh * 16);
        }
        __builtin_amdgcn_sched_barrier(0);
        __builtin_amdgcn_s_setprio(1);
#pragma unroll
        for (int kb = 0; kb < 4; ++kb) st[kb] = MFMA32(kf[s & 1][kb], qf[s], st[kb]);
        __builtin_amdgcn_s_setprio(0);
        __builtin_amdgcn_sched_barrier(0);
      }
    }
    float mx = st[0][0];
#pragma unroll
    for (int kb = 0; kb < 4; ++kb)
#pragma unroll
      for (int i = 0; i < 16; ++i) mx = fmaxf(mx, st[kb][i]);
    mx = fmaxf(mx, __shfl_xor(mx, 32));
    const float mn = fmaxf(m, mx);
    const float alpha = __builtin_amdgcn_exp2f(m - mn);
    m = mn;
    float ps = 0.f;
#pragma unroll
    for (int kb = 0; kb < 4; ++kb)
#pragma unroll
      for (int i = 0; i < 16; ++i) { st[kb][i] = __builtin_amdgcn_exp2f(st[kb][i] - mn); ps += st[kb][i]; }
    lsum = lsum * alpha + ps;
#pragma unroll
    for (int i = 0; i < 16; ++i) { O[0][i] *= alpha; O[1][i] *= alpha; }
    {
      u32x4 vfr[2][2];
#pragma unroll
      for (int vb = 0; vb < 2; ++vb) {
        const char* vp = Vs + (vb * 32 + lr) * VROW + (4 * lh) * 2;
        const uint2 v0 = *(const uint2*)(vp);
        const uint2 v1 = *(const uint2*)(vp + 16);
        vfr[0][vb] = (u32x4){v0.x, v0.y, v1.x, v1.y};
      }
#pragma unroll
      for (int step = 0; step < 8; ++step) {
        const int kb = step >> 1, s2 = step & 1;
        if (step < 7) {
          const int kb2 = (step + 1) >> 1, s22 = (step + 1) & 1;
#pragma unroll
          for (int vb = 0; vb < 2; ++vb) {
            const char* vp = Vs + (vb * 32 + lr) * VROW + (kb2 * 32 + 16 * s22 + 4 * lh) * 2;
            const uint2 v0 = *(const uint2*)(vp);
            const uint2 v1 = *(const uint2*)(vp + 16);
            vfr[(step + 1) & 1][vb] = (u32x4){v0.x, v0.y, v1.x, v1.y};
          }
        }
        u32x4 pk;
        pk.x = pack2(st[kb][8 * s2 + 0], st[kb][8 * s2 + 1]);
        pk.y = pack2(st[kb][8 * s2 + 2], st[kb][8 * s2 + 3]);
        pk.z = pack2(st[kb][8 * s2 + 4], st[kb][8 * s2 + 5]);
        pk.w = pack2(st[kb][8 * s2 + 6], st[kb][8 * s2 + 7]);
        const bf16x8 bfrag = __builtin_bit_cast(bf16x8, pk);
        __builtin_amdgcn_sched_barrier(0);
        O[0] = MFMA32(__builtin_bit_cast(bf16x8, vfr[step & 1][0]), bfrag, O[0]);
        O[1] = MFMA32(__builtin_bit_cast(bf16x8, vfr[step & 1][1]), bfrag, O[1]);
        __builtin_amdgcn_sched_barrier(0);
      }
    }
    if (more) store_tiles((kt + 1) & 1);
    __syncthreads();
  }
  const float ltot = lsum + __shfl_xor(lsum, 32);
  const float inv = 1.f / ltot;
  u16* op = p.ACT + qrow * DM + hh * 64;
#pragma unroll
  for (int vb = 0; vb < 2; ++vb)
#pragma unroll
    for (int g = 0; g < 4; ++g) {
      uint2 o;
      o.x = pack2(O[vb][4 * g] * inv, O[vb][4 * g + 1] * inv);
      o.y = pack2(O[vb][4 * g + 2] * inv, O[vb][4 * g + 3] * inv);
      *(uint2*)(op + vb * 32 + 8 * g + 4 * lh) = o;
    }
}

DI void final_tile(const Params& p, int t) {
  const int tid_ = opq(threadIdx.x & 255); const int lane = tid_ & 63, wid = tid_ >> 6;
  float4 G[4];
#pragma unroll
  for (int j = 0; j < 4; ++j) G[j] = *(const float4*)(p.final_g + lane * 4 + 256 * j);
  float* h0 = p.Hl + ((size_t)t * 32 + wid * 8) * DM;
#pragma unroll 1
  for (int rr = 0; rr < 8; rr += 2) {
    float4 v[2][4];
    float ss[2] = {0.f, 0.f};
#pragma unroll
    for (int u = 0; u < 2; ++u)
#pragma unroll
      for (int j = 0; j < 4; ++j) v[u][j] = *(const float4*)(h0 + (size_t)(rr + u) * DM + lane * 4 + 256 * j);
#pragma unroll
    for (int u = 0; u < 2; ++u)
#pragma unroll
      for (int j = 0; j < 4; ++j)
        ss[u] += v[u][j].x * v[u][j].x + v[u][j].y * v[u][j].y + v[u][j].z * v[u][j].z + v[u][j].w * v[u][j].w;
    ss[0] = wave_sum(ss[0]); ss[1] = wave_sum(ss[1]);
#pragma unroll
    for (int u = 0; u < 2; ++u) {
      const float r = rsqrtf(ss[u] * (1.f / DM) + 1e-6f);
#pragma unroll
      for (int j = 0; j < 4; ++j)
        *(float4*)(h0 + (size_t)(rr + u) * DM + lane * 4 + 256 * j) =
            make_float4(v[u][j].x * r * G[j].x, v[u][j].y * r * G[j].y, v[u][j].z * r * G[j].z, v[u][j].w * r * G[j].w);
    }
  }
}

#define XB_TMO      128
#define XB_XCNT(j)  (256  + 64 * (j))
#define XB_XSUB(j)  (1280 + 64 * (j))
#define XB_XGEN(j)  (2304 + 64 * (j))
#define XB_TOP      3328
#define XB_TOPGEN   3392
#define XCD_BAR_WORDS 3456
#define XB_SPIN_CAP (1u << 22)
#define LAS __attribute__((address_space(3)))
DI unsigned xb_ld(unsigned* p) { return __hip_atomic_load(p, __ATOMIC_RELAXED, __HIP_MEMORY_SCOPE_AGENT); }
DI unsigned xb_add(unsigned* p, unsigned v) { return __hip_atomic_fetch_add(p, v, __ATOMIC_RELAXED, __HIP_MEMORY_SCOPE_AGENT); }
DI unsigned xb_xcc_id() { return (unsigned)__builtin_amdgcn_s_getreg((3 << 11) | 20) & 0xFu; }
#define XB_SPIN(cond, bar) do { unsigned _sp = 0; while (cond) { __builtin_amdgcn_s_sleep(1); \
    if ((++_sp & 255u) == 0u) { if (xb_ld(&(bar)[XB_TMO])) break; if (_sp > XB_SPIN_CAP) { atomicAdd(&(bar)[XB_TMO], 1u); break; } } } } while (0)
struct XcdBarrier { unsigned* bar; unsigned x; volatile LAS unsigned* st; };
DI XcdBarrier xcd_barrier_post(unsigned* bar, volatile LAS unsigned* st) {
  XcdBarrier b; b.bar = bar; b.x = xb_xcc_id(); b.st = st;
  if (threadIdx.x == 0) (void)xb_add(&bar[XB_XCNT(b.x)], 1u);
  return b;
}
DI void xcd_barrier_complete(unsigned* bar, unsigned x, unsigned& nloc, unsigned& nx) {
  const unsigned G = gridDim.x * gridDim.y * gridDim.z;
  unsigned sum, cnt, mine, sp = 0u;
  for (;;) {
    sum = 0u; cnt = 0u; mine = 0u;
#pragma unroll
    for (unsigned j = 0; j < 16; ++j) { const unsigned c = xb_ld(&bar[XB_XCNT(j)]); sum += c; cnt += (c > 0u) ? 1u : 0u; mine = (j == x) ? c : mine; }
    if (sum == G) break;
    __builtin_amdgcn_s_sleep(1);
    if ((++sp & 255u) == 0u) { if (xb_ld(&bar[XB_TMO])) break; if (sp > XB_SPIN_CAP) { atomicAdd(&bar[XB_TMO], 1u); break; } }
  }
  nloc = mine > 0u ? mine : 1u; nx = cnt > 0u ? cnt : 1u;
}
DI void xcd_barrier(const XcdBarrier& b) {
  asm volatile("s_waitcnt vmcnt(0)" ::: "memory");
  __syncthreads();
  if (threadIdx.x == 0) {
    unsigned* bar = b.bar;
    __builtin_amdgcn_s_waitcnt(0);
    unsigned nloc = b.st[0], nx = b.st[1];
    if (nloc == 0u) { xcd_barrier_complete(bar, b.x, nloc, nx); b.st[0] = nloc; b.st[1] = nx; }
    const unsigned old = xb_add(&bar[XB_XSUB(b.x)], 1u);
    const unsigned gen = old / nloc;
    if (old + 1u == (gen + 1u) * nloc) {
      __builtin_amdgcn_fence(__ATOMIC_RELEASE, "agent");
      asm volatile("s_waitcnt vmcnt(0)" ::: "memory");
      const unsigned og = xb_add(&bar[XB_TOP], 1u);
      const unsigned tg = og / nx;
      if (og + 1u == (tg + 1u) * nx) xb_add(&bar[XB_TOPGEN], 1u);
      else XB_SPIN(xb_ld(&bar[XB_TOPGEN]) == tg, bar);
      __builtin_amdgcn_fence(__ATOMIC_ACQUIRE, "agent");
      xb_add(&bar[XB_XGEN(b.x)], 1u);
      asm volatile("s_waitcnt vmcnt(0)" ::: "memory");
    } else {
      XB_SPIN(xb_ld(&bar[XB_XGEN(b.x)]) == gen, bar);
      __builtin_amdgcn_fence(__ATOMIC_ACQUIRE, "agent");
      asm volatile("s_waitcnt vmcnt(0)" ::: "memory");
    }
  }
  __syncthreads();
}

__global__ void __launch_bounds__(256, 2) mega(Params p) {
  extern __shared__ __attribute__((aligned(16))) char smem[];
  cg::grid_group grid = cg::this_grid();
  const int bid = blockIdx.x, nb = gridDim.x;
  volatile LAS unsigned* xb_st = (volatile LAS unsigned*)(smem + SMEM_BYTES - 32);
  if (threadIdx.x < 2) xb_st[threadIdx.x] = 0u;
  if (bid == 0) for (int i = threadIdx.x; i < XCD_BAR_WORDS; i += 256) p.bar[i] = 0u;
  __syncthreads();

  {
    const size_t nx4 = (size_t)NB * SEQ * DM / 4, nc4 = (size_t)NB * CTXL * DM / 4;
    const float4* xs4 = (const float4*)p.x; float4* xd4 = (float4*)p.Hl;
    for (size_t i = (size_t)bid * 256 + threadIdx.x; i < nx4; i += (size_t)nb * 256) xd4[i] = xs4[i];
    const float4* cs4 = (const float4*)p.ctx; float4* cd4 = (float4*)p.Hc;
    for (size_t i = (size_t)bid * 256 + threadIdx.x; i < nc4; i += (size_t)nb * 256) cd4[i] = cs4[i];
  }
  for (int t = bid; t < DEPTH * WT_LAYER; t += nb) wconv_tile(p, t, smem);
  for (int t = bid; t < DEPTH * 96; t += nb) ada_tile(p, t, smem);
  if (bid == nb - 1) tables(p);
  if (bid == 0 && threadIdx.x < 8) p.ctr[threadIdx.x] = 0;
  grid.sync();
  const XcdBarrier xb = xcd_barrier_post(p.bar, xb_st);

#pragma unroll 1
  for (int l = 0; l < DEPTH; ++l) {
    const u16* Wl = p.W + (size_t)l * W_LAYER;
    for (int t = bid; t < MROWS / 32; t += nb) norm_tile(p, l, 0, t);
    xcd_barrier(xb);
    gemm_phase<EPI_P, false, true>(p, l, p.ACT, DM, Wl + W_IN, 1024, INP / 128, 0, smem, bid, nb);
    xcd_barrier(xb);
    for (int t = bid; t < MROWS / 32; t += nb) ssmprep_tile(p, l, t);
    gemm_phase<EPI_Q, true, false>(p, l, p.P, INP, Wl + W_Q, 384, 6, 0, smem, bid, nb);
    gemm_phase<EPI_KV, true, true>(p, l, p.P + 384, INP, Wl + W_KV, 256, 8, 0, smem, bid, nb);
    for (int t = bid; t < MT; t += nb) krope_tile(p, t);
    xcd_barrier(xb);
    if (bid < 128) hgrn_chain(p, l, bid, smem);
    else if (bid < 256) ssm_chain(p, l, bid - 128, smem);
    {
      volatile int* s_tile = (volatile int*)(smem + SMEM_BYTES - 16);
      for (;;) {
        __syncthreads();
        if (threadIdx.x == 0) *s_tile = atomicAdd(p.ctr + l, 1);
        __syncthreads();
        const int t = *s_tile;
        if (t >= NB * 8 * 34) break;
        if (t < NB * 8 * 32) attn_tile(p, t >> 5, 2 + (t & 31), smem);
        else attn_tile(p, (t - NB * 8 * 32) >> 1, t & 1, smem);
      }
    }
    xcd_barrier(xb);
    for (int t = bid; t < MROWS / 32; t += nb) readout_tile(p, l, t);
    xcd_barrier(xb);
    gemm_phase<EPI_RES, false, true>(p, l, p.ACT, DM, Wl + W_OUT, 1024, 8, 2048, smem, bid, nb);
    xcd_barrier(xb);
    for (int t = bid; t < MROWS / 32; t += nb) norm_tile(p, l, 1, t);
    xcd_barrier(xb);
    gemm_phase<EPI_SWIGLU, false, true>(p, l, p.ACT, DM, Wl + W_FI, 1024, 44, 0, smem, bid, nb);
    xcd_barrier(xb);
    gemm_phase<EPI_RES, false, true>(p, l, p.P, FFH, Wl + W_FO, FFH, 8, 5120, smem, bid, nb);
    xcd_barrier(xb);
  }
  for (int t = bid; t < NB * SEQ / 32; t += nb) final_tile(p, t);
}

constexpr size_t SMEM8 = 155648;
constexpr size_t HALF_LDS = 76800;

__global__ void __launch_bounds__(512, 2) mega8(Params p) {
  extern __shared__ __attribute__((aligned(16))) char smem[];
  cg::grid_group grid = cg::this_grid();
  const int bid = blockIdx.x, nb = gridDim.x;
  const int half = __builtin_amdgcn_readfirstlane(threadIdx.x >> 8);
  const int vb = 2 * bid + half, nvb = 2 * nb;
  char* hsm = smem + (size_t)half * HALF_LDS;
  volatile LAS unsigned* xb_st = (volatile LAS unsigned*)(smem + SMEM8 - 32);
  if (threadIdx.x < 2) xb_st[threadIdx.x] = 0u;
  if (bid == 0) for (int i = threadIdx.x; i < XCD_BAR_WORDS; i += 512) p.bar[i] = 0u;
  __syncthreads();

  for (int t = vb; t < DEPTH * WT_LAYER; t += nvb) wconv_tile(p, t, hsm);
  for (int t = vb; t < DEPTH * 96; t += nvb) ada_tile(p, t, hsm);
  if (bid == nb - 1) tables(p);
  if (bid == 0 && threadIdx.x < 8) p.ctr[threadIdx.x] = 0;
  grid.sync();
  const XcdBarrier xb = xcd_barrier_post(p.bar, xb_st);

#pragma unroll 1
  for (int l = 0; l < DEPTH; ++l) {
    const u16* Wl = p.W + (size_t)l * W_LAYER;
    const bool lastl = (l == DEPTH - 1);
    for (int t = vb; t < MROWS / 32; t += nvb) norm_tile(p, l, 0, t, l == 0);
    xcd_barrier(xb);
    gemm_phase8<EPI_P, false>(p, l, p.ACT, DM, Wl + W_IN, 1024, INP / 256, 0, smem);
    xcd_barrier(xb);
    for (int t = vb; t < MROWS / 32; t += nvb) ssmprep_tile(p, l, t);
    gemm_phase<EPI_Q, true, false>(p, l, p.P, INP, Wl + W_Q, 384, 6, 0, hsm, vb, nvb);
    gemm_phase8<EPI_KV, true>(p, l, p.P + 384, INP, Wl + W_KV, 256, 4, 0, smem);
    for (int t = vb; t < MT; t += nvb) krope_tile(p, t);
    xcd_barrier(xb);
    if (vb < 128) hgrn_chain(p, l, vb, hsm);
    else if (vb < 256) ssm_chain(p, l, vb - 128, hsm);
    {
      volatile int* s_tile = (volatile int*)(smem + SMEM8 - 16);
      for (;;) {
        __syncthreads();
        if (threadIdx.x == 0) *s_tile = atomicAdd(p.ctr + l, 1);
        __syncthreads();
        const int t = *s_tile;
        if (t >= (lastl ? NB * 8 * 16 : NB * 8 * 17)) break;
        if (t < NB * 8 * 16) attn_tile8(p, t >> 4, 1 + (t & 15), smem);
        else attn_tile8(p, t - NB * 8 * 16, 0, smem);
      }
    }
    xcd_barrier(xb);
    for (int t = vb; t < MROWS / 32; t += nvb) readout_tile(p, l, t);
    xcd_barrier(xb);
    gemm_phase8<EPI_RES, false>(p, l, p.ACT, DM, Wl + W_OUT, 1024, 4, 2048, smem, lastl);
    xcd_barrier(xb);
    for (int t = vb; t < MROWS / 32; t += nvb) if (!lastl || (t % (TPB / 32)) >= CTXL / 32) norm_tile(p, l, 1, t);
    xcd_barrier(xb);
    gemm_phase8<EPI_SWIGLU, false>(p, l, p.ACT, DM, Wl + W_FI, 1024, 22, 0, smem, lastl);
    xcd_barrier(xb);
    gemm_phase8<EPI_RES, false>(p, l, p.P, FFH, Wl + W_FO, FFH, 4, 5120, smem, lastl);
    xcd_barrier(xb);
  }
  for (int t = vb; t < NB * SEQ / 32; t += nvb) final_tile(p, t);
}

extern "C" void kernel_launch(void* const* d_in, const int* in_sizes, int n_in, void* d_out, int out_size, void* d_ws,
                              size_t ws_size, hipStream_t stream) {
  static int grid_blocks = 0;
  if (!grid_blocks) {
    hipFuncSetAttribute((const void*)mega8, hipFuncAttributeMaxDynamicSharedMemorySize, (int)SMEM8);
    int dev = 0, cus = 0, per_cu = 0;
    hipGetDevice(&dev);
    hipDeviceGetAttribute(&cus, hipDeviceAttributeMultiprocessorCount, dev);
    hipOccupancyMaxActiveBlocksPerMultiprocessor(&per_cu, mega8, 512, SMEM8);
    if (per_cu > 1) per_cu = 1;
    grid_blocks = cus * per_cu;
  }
  Params p{};
  const float* const* in = (const float* const*)d_in;
  p.x = in[0]; p.c = in[1]; p.ctx = in[2]; p.c_ctx = in[3]; p.w_ada = in[4]; p.b_ada = in[5]; p.norm1_g = in[6];
  p.norm2_g = in[7]; p.w_in = in[8]; p.qa_g = in[9]; p.wqb = in[10]; p.kva_g = in[11]; p.wkvb = in[12];
  p.lb_logits = in[13]; p.hg_norm_g = in[14]; p.conv_w = in[15]; p.conv_b = in[16]; p.dt_bias = in[17];
  p.a_log = in[18]; p.ssm_d = in[19]; p.ssm_norm_g = in[20]; p.w_out = in[21]; p.w_ffn_in = in[22];
  p.w_ffn_out = in[23]; p.final_g = in[24];
  p.Hl = (float*)d_out;
  char* ws = (char*)d_ws;
  size_t off = 0;
  auto take = [&](size_t bytes) { char* r = ws + off; off += (bytes + 255) & ~(size_t)255; return r; };
  p.W = (u16*)take((size_t)DEPTH * W_LAYER * 2);
  p.mod = (float*)take((size_t)DEPTH * 17 * 6144 * 4);
  p.rope = (float*)take(64 * 8 * 2 * 4);
  p.lbt = (float*)take(DEPTH * 2 * 256 * 4);
  p.Hc = (float*)take((size_t)NB * CTXL * DM * 4);
  p.ACT = (u16*)take((size_t)MROWS * DM * 2);
  p.P = (u16*)take((size_t)MROWS * INP * 2);
  p.Q = (u16*)take((size_t)MROWS * 768 * 2);
  p.Kn = (u16*)take((size_t)MROWS * 512 * 2);
  p.Vt = (u16*)take((size_t)MROWS * 512 * 2);
  p.KR = (u16*)take((size_t)MROWS * 32 * 2);
  p.RO = (u16*)take((size_t)MROWS * 512 * 2);
  p.RY = (u16*)take((size_t)MROWS * 512 * 2);
  p.ctr = (int*)take(256);
  p.DTA = (float*)take((size_t)MROWS * 16 * 4);
  p.bar = (unsigned*)take(XCD_BAR_WORDS * 4);
  if (off > ws_size) fprintf(stderr, "workspace too small: need %zu have %zu\n", off, ws_size);
  void* args[] = {&p};
  hipError_t e = hipLaunchCooperativeKernel((const void*)mega8, dim3(grid_blocks), dim3(512), args, SMEM8, stream);
  if (e != hipSuccess) fprintf(stderr, "cooperative launch failed: %s (grid %d)\n", hipGetErrorString(e), grid_blocks);
}
```
